# Optimizing an MI355X kernel written in HIP

```python
import jax, jax.numpy as jnp
from jax import lax
import numpy as np

D_MODEL = 1024
BATCH = 8
SEQ = 4096
DEPTH = 4

N_MIXERS = 3
BLOCK = 128
ROPE_THETA = 500000.0
ROPE_FRAC = 4
EPS = 1e-6
NEG_INF = -1e30

A_HEADS = 8
A_QK_DIM = 128
A_ROPE_DIM = A_QK_DIM // ROPE_FRAC
A_NOPE_DIM = A_QK_DIM - A_ROPE_DIM
A_V_DIM = 128
A_KV_RANK = 256
IDX_HEADS = 16
IDX_DIM = 64
TOPK_MAX = 256

B_HEADS = 16
B_KV_HEADS = 4
B_HEAD_DIM = 64
B_WINDOW = 128

C_HEADS = 8
C_HEAD_DIM = 128
C_BRANCHES = ((128, 1), (512, 4), (2048, 16))

MEM_LEN = 256
MEM_HEADS = 4
MEM_HEAD_DIM = 64
MEM_WIDTH = MEM_HEADS * MEM_HEAD_DIM

D_FF = 2816
CONV_WIDTH = 3

MIX_WIDTH = 1024
OUT_IN = MIX_WIDTH + MEM_WIDTH
A_SPLITS = (A_HEADS * A_QK_DIM, A_KV_RANK, A_ROPE_DIM, IDX_HEADS * IDX_DIM, IDX_DIM, IDX_HEADS, MEM_WIDTH)
B_SPLITS = (B_HEADS * B_HEAD_DIM, B_KV_HEADS * B_HEAD_DIM, B_KV_HEADS * B_HEAD_DIM, MEM_WIDTH)
C_SPLITS = (C_HEADS * C_HEAD_DIM, C_HEADS * C_HEAD_DIM, C_HEADS * C_HEAD_DIM, MEM_WIDTH)
N_A = len(range(0, DEPTH, N_MIXERS))
N_B = len(range(1, DEPTH, N_MIXERS))
N_C = len(range(2, DEPTH, N_MIXERS))

kernel_name = 'hybrid_dsa_swa_dilated_memory_convffn'


def rmsnorm(x, g):
    xf = x.astype(jnp.float32)
    y = xf * lax.rsqrt(jnp.mean(xf * xf, axis=-1, keepdims=True) + EPS)
    return (y * g.astype(jnp.float32)).astype(x.dtype)


def split_cols(t, sizes):
    return jnp.split(t, np.cumsum(sizes)[:-1].tolist(), axis=-1)


def rope_tables(positions, rot_dim):
    inv = ROPE_THETA ** (-jnp.arange(0, rot_dim, 2, dtype=jnp.float32) / rot_dim)
    ang = positions.astype(jnp.float32)[..., None] * inv
    return jnp.cos(ang), jnp.sin(ang)


def apply_partial_rope(x, cos, sin):
    half = cos.shape[-1]
    rot = 2 * half
    xf = x[..., :rot].astype(jnp.float32)
    x1, x2 = xf[..., :half], xf[..., half:]
    c, s = cos[:, :, None, :], sin[:, :, None, :]
    xr = jnp.concatenate([x1 * c - x2 * s, x2 * c + x1 * s], axis=-1).astype(x.dtype)
    return jnp.concatenate([xr, x[..., rot:]], axis=-1)


def banded_window_attention(q, k, v, max_dist, scale, sink=None):
    B, n = q.shape[0], q.shape[1]
    nb = -(-n // BLOCK)
    pad = nb * BLOCK - n
    if pad:
        q = jnp.pad(q, ((0, 0), (0, pad), (0, 0), (0, 0), (0, 0)))
        k = jnp.pad(k, ((0, 0), (0, pad), (0, 0), (0, 0)))
        v = jnp.pad(v, ((0, 0), (0, pad), (0, 0), (0, 0)))
    qb = q.reshape(B, nb, BLOCK, *q.shape[2:])
    kb = k.reshape(B, nb, BLOCK, *k.shape[2:])
    vb = v.reshape(B, nb, BLOCK, *v.shape[2:])
    prev = ((0, 0), (1, 0), (0, 0), (0, 0), (0, 0))
    kk = jnp.concatenate([jnp.pad(kb[:, :-1], prev), kb], axis=2)
    vv = jnp.concatenate([jnp.pad(vb[:, :-1], prev), vb], axis=2)
    s = jnp.einsum('bnqhgd,bnkhd->bnhgqk', qb, kk).astype(jnp.float32) * scale
    qi = jnp.arange(BLOCK)[:, None]
    kj = jnp.arange(2 * BLOCK)[None, :]
    dist = BLOCK + qi - kj
    band = (dist >= 0) & (dist <= max_dist)
    blk = jnp.arange(nb)[:, None, None]
    mask = band[None] & ((blk > 0) | (kj >= BLOCK)[None])
    s = jnp.where(mask[None, :, None, None], s, NEG_INF)
    m = jnp.max(s, axis=-1)
    if sink is not None:
        sk = sink.astype(jnp.float32)[None, None, :, :, None]
        m = jnp.maximum(m, sk)
    p = jnp.exp(s - m[..., None])
    l = jnp.sum(p, axis=-1)
    if sink is not None:
        l = l + jnp.exp(sk - m)
    p = p / l[..., None]
    o = jnp.einsum('bnhgqk,bnkhd->bnqhgd', p, vv.astype(jnp.float32))
    o = o.reshape(B, nb * BLOCK, *o.shape[3:])[:, :n].astype(q.dtype)
    lse = (m + jnp.log(l)).transpose(0, 1, 4, 2, 3)
    lse = lse.reshape(B, nb * BLOCK, *lse.shape[3:])[:, :n]
    return o, lse


def dsa_attention(q_nope, q_rope, c_kv, k_rope, q_idx, k_idx, w_idx, w_uk, w_uv):
    B, S = q_nope.shape[0], q_nope.shape[1]
    topk = min(TOPK_MAX, S // 4)
    nb = S // BLOCK
    scale = A_QK_DIM ** -0.5
    q_lat = jnp.einsum('bshn,rhn->bshr', q_nope, w_uk)
    key_pos = jnp.arange(S)

    def to_blocks(t):
        return t.reshape(B, nb, BLOCK, *t.shape[2:]).swapaxes(0, 1)

    def one_block(args):
        ql, qr, qi, wi, t = args
        dots = jnp.einsum('bqhd,bsd->bqhs', qi, k_idx).astype(jnp.float32)
        score = jnp.einsum('bqhs,bqh->bqs', jax.nn.relu(dots), wi.astype(jnp.float32))
        causal = key_pos[None, :] <= t[:, None]
        score = jnp.where(causal[None], score, -jnp.inf)
        _, idx = lax.top_k(score, topk)
        c_sel = jax.vmap(lambda c, i: c[i])(c_kv, idx)
        kr_sel = jax.vmap(lambda c, i: c[i])(k_rope, idx)
        s = (jnp.einsum('bqhr,bqkr->bqhk', ql, c_sel)
             + jnp.einsum('bqhe,bqke->bqhk', qr, kr_sel)).astype(jnp.float32) * scale
        valid = idx <= t[None, :, None]
        s = jnp.where(valid[:, :, None, :], s, NEG_INF)
        p = jax.nn.softmax(s, axis=-1)
        return jnp.einsum('bqhk,bqkr->bqhr', p, c_sel.astype(jnp.float32)).astype(ql.dtype)

    t_ids = jnp.arange(S).reshape(nb, BLOCK)
    o_lat = lax.map(one_block, (to_blocks(q_lat), to_blocks(q_rope), to_blocks(q_idx), to_blocks(w_idx), t_ids))
    o_lat = o_lat.swapaxes(0, 1).reshape(B, S, A_HEADS, A_KV_RANK)
    return jnp.einsum('bshr,rhv->bshv', o_lat, w_uv)


def mixer_a(h, cos32, sin32, cos16, sin16, w_in, kv_norm, w_uk, w_uv):
    B, S, _ = h.shape
    q, c_kv, k_rope, q_idx, k_idx, w_idx, q_mem = split_cols(h @ w_in, A_SPLITS)
    q = apply_partial_rope(q.reshape(B, S, A_HEADS, A_QK_DIM), cos32, sin32)
    q_rope, q_nope = q[..., :A_ROPE_DIM], q[..., A_ROPE_DIM:]
    k_rope = apply_partial_rope(k_rope[:, :, None, :], cos32, sin32)[:, :, 0]
    c_kv = rmsnorm(c_kv, kv_norm)
    q_idx = apply_partial_rope(q_idx.reshape(B, S, IDX_HEADS, IDX_DIM), cos16, sin16)
    k_idx = apply_partial_rope(k_idx[:, :, None, :], cos16, sin16)[:, :, 0]
    w_idx = w_idx * (IDX_HEADS * IDX_DIM) ** -0.5
    o = dsa_attention(q_nope, q_rope, c_kv, k_rope, q_idx, k_idx, w_idx, w_uk, w_uv)
    return o.reshape(B, S, A_HEADS * A_V_DIM), q_mem


def mixer_b(h, cos16, sin16, w_in, sinks):
    B, S, _ = h.shape
    q, k, v, q_mem = split_cols(h @ w_in, B_SPLITS)
    group = B_HEADS // B_KV_HEADS
    q = apply_partial_rope(q.reshape(B, S, B_HEADS, B_HEAD_DIM), cos16, sin16)
    k = apply_partial_rope(k.reshape(B, S, B_KV_HEADS, B_HEAD_DIM), cos16, sin16)
    v = v.reshape(B, S, B_KV_HEADS, B_HEAD_DIM)
    q = q.reshape(B, S, B_KV_HEADS, group, B_HEAD_DIM)
    o, _ = banded_window_attention(q, k, v, B_WINDOW - 1, B_HEAD_DIM ** -0.5,
                                   sink=sinks.reshape(B_KV_HEADS, group))
    return o.reshape(B, S, B_HEADS * B_HEAD_DIM), q_mem


def dilate(t, d):
    B, S = t.shape[0], t.shape[1]
    return t.reshape(B, S // d, d, *t.shape[2:]).swapaxes(1, 2).reshape(B * d, S // d, *t.shape[2:])


def undilate(t, d, B):
    n = t.shape[1]
    return t.reshape(B, d, n, *t.shape[2:]).swapaxes(1, 2).reshape(B, n * d, *t.shape[2:])


def mixer_c(h, cos32, sin32, w_in):
    B, S, _ = h.shape
    q, k, v, q_mem = split_cols(h @ w_in, C_SPLITS)
    q = apply_partial_rope(q.reshape(B, S, C_HEADS, C_HEAD_DIM), cos32, sin32)
    k = apply_partial_rope(k.reshape(B, S, C_HEADS, C_HEAD_DIM), cos32, sin32)
    v = v.reshape(B, S, C_HEADS, C_HEAD_DIM)
    outs, lses = [], []
    for window, d in C_BRANCHES:
        o_g, lse_g = banded_window_attention(dilate(q, d)[:, :, :, None], dilate(k, d), dilate(v, d),
                                             window // d, C_HEAD_DIM ** -0.5)
        outs.append(undilate(o_g[:, :, :, 0], d, B))
        lses.append(undilate(lse_g[..., 0], d, B))
    alpha = jax.nn.softmax(jnp.stack(lses), axis=0)
    o = jnp.sum(alpha[..., None] * jnp.stack(outs).astype(jnp.float32), axis=0).astype(h.dtype)
    return o.reshape(B, S, C_HEADS * C_HEAD_DIM), q_mem


def memory_cross_attention(q_mem, mem_n, w_mem_kv):
    B, S, _ = q_mem.shape
    k, v = jnp.split(mem_n @ w_mem_kv, 2, axis=-1)
    k = k.reshape(B, -1, MEM_HEADS, MEM_HEAD_DIM)
    v = v.reshape(B, -1, MEM_HEADS, MEM_HEAD_DIM)
    q = q_mem.reshape(B, S, MEM_HEADS, MEM_HEAD_DIM)
    s = jnp.einsum('bshd,bmhd->bhsm', q, k).astype(jnp.float32) * MEM_HEAD_DIM ** -0.5
    p = jax.nn.softmax(s, axis=-1)
    o = jnp.einsum('bhsm,bmhd->bshd', p, v.astype(jnp.float32)).astype(q_mem.dtype)
    return o.reshape(B, S, MEM_WIDTH)


def conv_glu_ffn(h, w_up, conv_w, conv_b, w_down):
    S = h.shape[1]
    a, b = jnp.split(h @ w_up, 2, axis=-1)
    a_pad = jnp.pad(a, ((0, 0), (CONV_WIDTH - 1, 0), (0, 0)))
    a = sum(conv_w[j] * a_pad[:, j:j + S] for j in range(CONV_WIDTH)) + conv_b
    return (jax.nn.silu(a) * b) @ w_down


def setup_inputs(seed: int = 0) -> dict:
    key = jax.random.key(seed)
    ks = iter(jax.random.split(key, 40))

    def w(shape, fan_in):
        return jax.random.normal(next(ks), shape, jnp.float32) * fan_in ** -0.5

    def gain(shape):
        return 1.0 + 0.02 * jax.random.normal(next(ks), shape, jnp.float32)

    x = jax.random.normal(next(ks), (BATCH, SEQ, D_MODEL), jnp.float32)
    mem = jax.random.normal(next(ks), (BATCH, MEM_LEN, D_MODEL), jnp.float32)
    offset = jax.random.randint(next(ks), (BATCH, 1), 0, 4096, dtype=jnp.int32)
    positions = offset + jnp.arange(SEQ, dtype=jnp.int32)[None, :]
    return {
        'x': x, 'mem': mem, 'positions': positions,
        'g_mix': gain((DEPTH, D_MODEL)), 'g_ffn': gain((DEPTH, D_MODEL)),
        'g_mem': gain((D_MODEL,)), 'g_final': gain((D_MODEL,)),
        'w_mem_kv': w((DEPTH, D_MODEL, 2 * MEM_WIDTH), D_MODEL),
        'a_w_in': w((N_A, D_MODEL, sum(A_SPLITS)), D_MODEL),
        'a_kv_norm': gain((N_A, A_KV_RANK)),
        'a_w_uk': w((N_A, A_KV_RANK, A_HEADS, A_NOPE_DIM), A_KV_RANK),
        'a_w_uv': w((N_A, A_KV_RANK, A_HEADS, A_V_DIM), A_KV_RANK),
        'a_w_out': w((N_A, OUT_IN, D_MODEL), OUT_IN),
        'b_w_in': w((N_B, D_MODEL, sum(B_SPLITS)), D_MODEL),
        'b_sinks': 0.5 * jax.random.normal(next(ks), (N_B, B_HEADS), jnp.float32),
        'b_w_out': w((N_B, OUT_IN, D_MODEL), OUT_IN),
        'c_w_in': w((N_C, D_MODEL, sum(C_SPLITS)), D_MODEL),
        'c_w_out': w((N_C, OUT_IN, D_MODEL), OUT_IN),
        'f_w_up': w((DEPTH, D_MODEL, 2 * D_FF), D_MODEL),
        'f_conv_w': w((DEPTH, CONV_WIDTH, D_FF), CONV_WIDTH),
        'f_conv_b': 0.02 * jax.random.normal(next(ks), (DEPTH, D_FF), jnp.float32),
        'f_w_down': w((DEPTH, D_FF, D_MODEL), D_FF),
    }


def reference(x, mem, positions, g_mix, g_ffn, g_mem, g_final, w_mem_kv,
              a_w_in, a_kv_norm, a_w_uk, a_w_uv, a_w_out,
              b_w_in, b_sinks, b_w_out, c_w_in, c_w_out,
              f_w_up, f_conv_w, f_conv_b, f_w_down):
    cos32, sin32 = rope_tables(positions, A_QK_DIM // ROPE_FRAC)
    cos16, sin16 = rope_tables(positions, B_HEAD_DIM // ROPE_FRAC)
    mem_n = rmsnorm(mem, g_mem)
    for i in range(DEPTH):
        kind, j = i % N_MIXERS, i // N_MIXERS
        h = rmsnorm(x, g_mix[i])
        if kind == 0:
            mix, q_mem = mixer_a(h, cos32, sin32, cos16, sin16, a_w_in[j], a_kv_norm[j], a_w_uk[j], a_w_uv[j])
            w_out = a_w_out[j]
        elif kind == 1:
            mix, q_mem = mixer_b(h, cos16, sin16, b_w_in[j], b_sinks[j])
            w_out = b_w_out[j]
        else:
            mix, q_mem = mixer_c(h, cos32, sin32, c_w_in[j])
            w_out = c_w_out[j]
        mem_o = memory_cross_attention(q_mem, mem_n, w_mem_kv[i])
        x = x + jnp.concatenate([mix, mem_o], axis=-1) @ w_out
        x = x + conv_glu_ffn(rmsnorm(x, g_ffn[i]), f_w_up[i], f_conv_w[i], f_conv_b[i], f_w_down[i])
    return rmsnorm(x, g_final)
```

```cpp
#include <hip/hip_runtime.h>
#include <cstdio>
#include <cstdint>
#include <cmath>

#define LAS __attribute__((address_space(3)))
#define GAS __attribute__((address_space(1)))
typedef unsigned short bf16_t;
typedef short bf16x8 __attribute__((ext_vector_type(8)));
typedef short s16x4 __attribute__((ext_vector_type(4)));
typedef float f32x4 __attribute__((ext_vector_type(4)));
typedef float f32x2 __attribute__((ext_vector_type(2)));
typedef float f32x16 __attribute__((ext_vector_type(16)));
typedef unsigned u32x4 __attribute__((ext_vector_type(4)));
typedef unsigned u32x2 __attribute__((ext_vector_type(2)));
typedef GAS unsigned gu32;

constexpr int BATCH = 8, SEQ = 4096, DM = 1024, MTOK = BATCH * SEQ, DEPTH = 4, FF = 2816, MEMLEN = 256;
constexpr int NWAVES = 8, NTHR = 512;
constexpr float EPS = 1e-6f;
constexpr float LOG2E = 1.4426950408889634f;
constexpr float NEGBIG = -1e30f;
constexpr float MASKV = -3.0e38f;
constexpr int NA_IN = 4096, NB_IN = 1792, NC_IN = 3328;
constexpr int LDOA = 2304, LDOB = 1280;
constexpr int CKVP = 288;

constexpr size_t MiB = 1u << 20;
constexpr size_t WS_CTL = 0, CTL_ZERO_BYTES = 1 * MiB;
constexpr size_t WS_COS32 = 1 * MiB, WS_SIN32 = 3 * MiB, WS_COS16 = 5 * MiB, WS_SIN16 = 6 * MiB;
constexpr size_t WS_MEMN = 7 * MiB;
constexpr size_t WS_KVM = 11 * MiB;
constexpr size_t WS_WT = 20 * MiB, WT_LAYER = 32 * MiB;
constexpr size_t WT_UP = 0, WT_DOWN = 11 * MiB, WT_MKV = 17 * MiB, WT_OUT = 18 * MiB, WT_IN = 23 * MiB;
constexpr size_t WS_XN = 148 * MiB;
constexpr size_t WS_ACT = 212 * MiB;
constexpr size_t WS_OA = WS_ACT, WS_QR = WS_ACT + 144 * MiB, WS_CKV = WS_ACT + 160 * MiB, WS_KI = WS_ACT + 178 * MiB, WS_WI = WS_ACT + 182 * MiB,
                 WS_QI = WS_ACT + 184 * MiB, WS_IDX = WS_ACT + 248 * MiB, WS_TMP = WS_ACT + 264 * MiB;
constexpr size_t WS_OB = WS_ACT, WS_KB = WS_ACT + 80 * MiB, WS_VB = WS_ACT + 96 * MiB;
constexpr size_t WS_OC = WS_ACT, WS_KC = WS_ACT + 80 * MiB, WS_VC = WS_ACT + 144 * MiB, WS_P2 = WS_ACT + 208 * MiB, WS_LSE = WS_ACT + 272 * MiB;
constexpr size_t WS_AH = WS_ACT, WS_BH = WS_ACT + 88 * MiB;
constexpr size_t WS_G = WS_ACT;
constexpr size_t WS_SSP = 508 * MiB;
constexpr size_t WS_END = 512 * MiB;
constexpr size_t TMP_STRIDE = 16 * MiB, TMP_WNAT = 0, TMP_WUKT = 6 * MiB, TMP_WUVN = 7 * MiB, TMP_WOT = 8 * MiB;

constexpr int CW_TMO = 0, CW_BAR = 4096;

constexpr int LDS_BYTES = 159744;
constexpr int MISC_OFF = 155648;

__device__ __forceinline__ unsigned f2bf(float f) { unsigned u = __builtin_bit_cast(unsigned, f); return (u + 0x7fffu + ((u >> 16) & 1u)) >> 16; }
__device__ __forceinline__ unsigned cvt_pk_bf16(float lo, float hi) { unsigned r; asm volatile("v_cvt_pk_bf16_f32 %0, %1, %2" : "=v"(r) : "v"(lo), "v"(hi)); return r; }
__device__ __forceinline__ float bf2f(unsigned short b) { return __builtin_bit_cast(float, (unsigned)b << 16); }
__device__ __forceinline__ float bflo(unsigned w) { return __builtin_bit_cast(float, w << 16); }
__device__ __forceinline__ float bfhi(unsigned w) { return __builtin_bit_cast(float, w & 0xffff0000u); }
__device__ __forceinline__ float wave_max(float v) {
#pragma unroll
    for (int o = 1; o < 64; o <<= 1) v = fmaxf(v, __shfl_xor(v, o));
    return v;
}
__device__ __forceinline__ float wave_min(float v) {
#pragma unroll
    for (int o = 1; o < 64; o <<= 1) v = fminf(v, __shfl_xor(v, o));
    return v;
}
__device__ __forceinline__ float fexp2(float x) { return __builtin_amdgcn_exp2f(x); }
__device__ __forceinline__ float xmax16(float v) { const unsigned u = __builtin_bit_cast(unsigned, v); const auto r = __builtin_amdgcn_permlane16_swap(u, u, false, false); const unsigned r0 = r[0], r1 = r[1]; const float a = __builtin_bit_cast(float, r0), b = __builtin_bit_cast(float, r1); return fmaxf(a, b); }
__device__ __forceinline__ float xmax32(float v) { const unsigned u = __builtin_bit_cast(unsigned, v); const auto r = __builtin_amdgcn_permlane32_swap(u, u, false, false); const unsigned r0 = r[0], r1 = r[1]; const float a = __builtin_bit_cast(float, r0), b = __builtin_bit_cast(float, r1); return fmaxf(a, b); }
__device__ __forceinline__ float xsum16(float v) { const unsigned u = __builtin_bit_cast(unsigned, v); const auto r = __builtin_amdgcn_permlane16_swap(u, u, false, false); const unsigned r0 = r[0], r1 = r[1]; const float a = __builtin_bit_cast(float, r0), b = __builtin_bit_cast(float, r1); return a + b; }
__device__ __forceinline__ float xsum32(float v) { const unsigned u = __builtin_bit_cast(unsigned, v); const auto r = __builtin_amdgcn_permlane32_swap(u, u, false, false); const unsigned r0 = r[0], r1 = r[1]; const float a = __builtin_bit_cast(float, r0), b = __builtin_bit_cast(float, r1); return a + b; }
__device__ __forceinline__ float wave_sum(float v) {
    v += __builtin_bit_cast(float, __builtin_amdgcn_mov_dpp(__builtin_bit_cast(int, v), 0xB1, 0xf, 0xf, false));
    v += __builtin_bit_cast(float, __builtin_amdgcn_mov_dpp(__builtin_bit_cast(int, v), 0x4E, 0xf, 0xf, false));
    v += __builtin_bit_cast(float, __builtin_amdgcn_mov_dpp(__builtin_bit_cast(int, v), 0x141, 0xf, 0xf, false));
    v += __builtin_bit_cast(float, __builtin_amdgcn_mov_dpp(__builtin_bit_cast(int, v), 0x140, 0xf, 0xf, false));
    return xsum32(xsum16(v));
}
#define DPPF(v_, ctl_) __builtin_bit_cast(float, __builtin_amdgcn_mov_dpp(__builtin_bit_cast(int, (v_)), (ctl_), 0xf, 0xf, false))
__device__ __forceinline__ float half_min(float v) {
    v = fminf(v, DPPF(v, 0xB1)); v = fminf(v, DPPF(v, 0x4E)); v = fminf(v, DPPF(v, 0x141)); v = fminf(v, DPPF(v, 0x140));
    const unsigned u = __builtin_bit_cast(unsigned, v); const auto r = __builtin_amdgcn_permlane16_swap(u, u, false, false); const unsigned r0 = r[0], r1 = r[1];
    return fminf(__builtin_bit_cast(float, r0), __builtin_bit_cast(float, r1));
}
__device__ __forceinline__ float half_max(float v) {
    v = fmaxf(v, DPPF(v, 0xB1)); v = fmaxf(v, DPPF(v, 0x4E)); v = fmaxf(v, DPPF(v, 0x141)); v = fmaxf(v, DPPF(v, 0x140));
    return xmax16(v);
}
__device__ __forceinline__ int crow(int r, int hi) { return (r & 3) + 8 * (r >> 2) + 4 * hi; }

#define XB_TMO      128
#define XB_XCNT(j)  (256  + 64 * (j))
#define XB_XSUB(j)  (1280 + 64 * (j))
#define XB_XGEN(j)  (2304 + 64 * (j))
#define XB_TOP      3328
#define XB_TOPGEN   3392
#define XCD_BAR_WORDS 3456
#define XB_SPIN_CAP (1u << 22)

__device__ __forceinline__ unsigned xb_ld(unsigned* p)              { return __hip_atomic_load(p, __ATOMIC_RELAXED, __HIP_MEMORY_SCOPE_AGENT); }
__device__ __forceinline__ unsigned xb_add(unsigned* p, unsigned v) { return __hip_atomic_fetch_add(p, v, __ATOMIC_RELAXED, __HIP_MEMORY_SCOPE_AGENT); }
__device__ __forceinline__ unsigned xb_xcc_id() { return (unsigned)__builtin_amdgcn_s_getreg((3 << 11) | 20) & 0xFu; }
#define XB_SPIN(cond, bar) do { unsigned _sp = 0; while (cond) { __builtin_amdgcn_s_sleep(1); \
    if ((++_sp & 255u) == 0u) { if (xb_ld(&(bar)[XB_TMO])) break; if (_sp > XB_SPIN_CAP) { atomicAdd(&(bar)[XB_TMO], 1u); break; } } } } while (0)

struct XcdBarrier { unsigned* bar; unsigned x; volatile LAS unsigned* st; int wave; };

__device__ __forceinline__ XcdBarrier xcd_barrier_post(unsigned* bar, volatile LAS unsigned* st) {
    XcdBarrier b; b.bar = bar; b.x = xb_xcc_id(); b.st = st;
    if (threadIdx.x == 0) (void)xb_add(&bar[XB_XCNT(b.x)], 1u);
    return b;
}
__device__ __forceinline__ void xcd_barrier_complete(unsigned* bar, unsigned x, unsigned& nloc, unsigned& nx) {
    const unsigned G = gridDim.x * gridDim.y * gridDim.z;
    unsigned sum, cnt, mine, sp = 0u;
    for (;;) {
        sum = 0u; cnt = 0u; mine = 0u;
#pragma unroll
        for (unsigned j = 0; j < 16; ++j) { const unsigned c = xb_ld(&bar[XB_XCNT(j)]); sum += c; cnt += (c > 0u) ? 1u : 0u; mine = (j == x) ? c : mine; }
        if (sum == G) break;
        __builtin_amdgcn_s_sleep(1);
        if ((++sp & 255u) == 0u) { if (xb_ld(&bar[XB_TMO])) break; if (sp > XB_SPIN_CAP) { atomicAdd(&bar[XB_TMO], 1u); break; } }
    }
    nloc = mine > 0u ? mine : 1u; nx = cnt > 0u ? cnt : 1u;
}
__device__ __forceinline__ void xcd_barrier(const XcdBarrier& b) {
    asm volatile("s_waitcnt vmcnt(0)" ::: "memory");
    __syncthreads();
    int bl_; asm volatile("v_mbcnt_lo_u32_b32 %0, -1, 0\n\tv_mbcnt_hi_u32_b32 %0, -1, %0" : "=v"(bl_));
    if (b.wave == 0 && bl_ == 0) {
        unsigned* bar = b.bar;
        __builtin_amdgcn_s_waitcnt(0);
        unsigned nloc = b.st[0], nx = b.st[1];
        if (nloc == 0u) { xcd_barrier_complete(bar, b.x, nloc, nx); b.st[0] = nloc; b.st[1] = nx; }
        const unsigned old = xb_add(&bar[XB_XSUB(b.x)], 1u);
        const unsigned gen = old / nloc;
        if (old + 1u == (gen + 1u) * nloc) {
            __builtin_amdgcn_fence(__ATOMIC_RELEASE, "agent");
            asm volatile("s_waitcnt vmcnt(0)" ::: "memory");
            const unsigned og = xb_add(&bar[XB_TOP], 1u);
            const unsigned tg = og / nx;
            if (og + 1u == (tg + 1u) * nx) xb_add(&bar[XB_TOPGEN], 1u);
            else XB_SPIN(xb_ld(&bar[XB_TOPGEN]) == tg, bar);
            __builtin_amdgcn_fence(__ATOMIC_ACQUIRE, "agent");
            xb_add(&bar[XB_XGEN(b.x)], 1u);
            asm volatile("s_waitcnt vmcnt(0)" ::: "memory");
        } else {
            XB_SPIN(xb_ld(&bar[XB_XGEN(b.x)]) == gen, bar);
            __builtin_amdgcn_fence(__ATOMIC_ACQUIRE, "agent");
            asm volatile("s_waitcnt vmcnt(0)" ::: "memory");
        }
    }
    __syncthreads();
}

namespace pg8 {
constexpr int BM = 256, BK = 64, HALF = 128, HTB = HALF * BK * 2, STAGE_BYTES = 8 * HTB, NXCD = 8, WGM = 8;
__device__ __forceinline__ int lds_byte(int r, int c) { const int st = (r >> 4) * 2 + (c >> 5), rr = r & 15, cc = c & 31, ob = rr * 64 + cc * 2; return st * 1024 + (ob ^ (((ob >> 9) & 1) << 5)); }
__device__ __forceinline__ void stage_rc(int b, int& R, int& C) { const int st = b / 1024, sb = b % 1024, swz = sb ^ (((sb >> 9) & 1) << 5); R = (st >> 1) * 16 + swz / 64; C = (st & 1) * 32 + (swz % 64) / 2; }
__device__ __forceinline__ int perm32(int rho) { const int n = rho >> 4, i = rho & 15; return 8 * (i >> 2) + 4 * n + (i & 3); }

struct Unit { int pm, pn; };
struct Gemm { const bf16_t* A; const bf16_t* Bt; int lda, ldb, K; };

struct StaticOrder {
    static constexpr bool OVL = false;
    int nM, nN, nwg, G, c;
    __device__ __forceinline__ long arow(const Unit& u) const { return (long)u.pm * BM; }
    __device__ void init(int M, int N, int G_, int c_) { nM = M / BM; nN = N / BM; nwg = nM * nN; G = G_; c = c_; }
    __device__ bool next(int i, Unit& u) const {
        const long L = (long)i * G + c; if (L >= nwg) return false;
        int wgid = (int)L; { const int q = nwg / NXCD, r = nwg % NXCD, xcd = wgid % NXCD, off = wgid / NXCD; wgid = (xcd < r ? xcd * (q + 1) : r * (q + 1) + (xcd - r) * q) + off; }
        const int nig = WGM * nN, gid = wgid / nig, fm = gid * WGM, gsz = (nM - fm) < WGM ? (nM - fm) : WGM;
        u.pm = fm + ((wgid % nig) % gsz); u.pn = (wgid % nig) / gsz; return true;
    }
};
struct OvlOrder {
    static constexpr bool OVL = true;
    int nM, nN, nwg, G, c;
    __device__ void init(int nM_, int nN_, int G_, int c_) { nM = nM_; nN = nN_; nwg = nM * nN; G = G_; c = c_; }
    __device__ bool next(int i, Unit& u) const {
        const long L = (long)i * G + c; if (L >= nwg) return false;
        int wgid = (int)L; { const int q = nwg / NXCD, r = nwg % NXCD, xcd = wgid % NXCD, off = wgid / NXCD; wgid = (xcd < r ? xcd * (q + 1) : r * (q + 1) + (xcd - r) * q) + off; }
        const int nig = WGM * nN, gid = wgid / nig, fm = gid * WGM, gsz = (nM - fm) < WGM ? (nM - fm) : WGM;
        u.pm = fm + ((wgid % nig) % gsz); u.pn = (wgid % nig) / gsz; return true;
    }
    __device__ __forceinline__ long arow(const Unit& u) const { return (long)(u.pm / 17) * 4096 + 248 * (u.pm % 17) - 2; }
};
struct OneUnit {
    static constexpr bool OVL = false;
    __device__ __forceinline__ long arow(const Unit& u) const { return (long)u.pm * BM; }
    int pm, pn; bool have;
    __device__ bool next(int i, Unit& u) const { if (i > 0 || !have) return false; u.pm = pm; u.pn = pn; return true; }
};

template <class Epi, class Sched>
__device__ __forceinline__ void gemm_phase(LAS unsigned char* lds, const Gemm g, const Sched& S, const Epi& E, int wave_) {
    int tid_; asm volatile("v_mbcnt_lo_u32_b32 %0, -1, 0\n\tv_mbcnt_hi_u32_b32 %0, -1, %0" : "=v"(tid_)); tid_ += wave_ * 64;
    const int tid = tid_, wid = __builtin_amdgcn_readfirstlane(tid >> 6), lane = tid & 63, wr = wid >> 2, wc = wid & 3, fr = lane & 15, fq = lane >> 4;
    const int K = g.K, nt = K / BK;
    unsigned voffA[2], voffB[2];
#pragma unroll
    for (int i = 0; i < 2; ++i) { int R, C; stage_rc(tid * 16 + i * 8192, R, C); const int Rb = Epi::PERM ? ((R & ~31) + perm32(R & 31)) : R;
        const int Ra = Sched::OVL ? 62 * (R >> 6) + 4 * (R & 15) + ((R >> 4) & 3) : R;
        voffA[i] = (unsigned)(Ra * g.lda + C) * 2u; voffB[i] = (unsigned)(Rb * g.ldb + C) * 2u; }
    const size_t kstep = (size_t)(BK * 2);
    const size_t hstepA = (size_t)(Sched::OVL ? HALF - 4 : HALF) * g.lda * 2, hstepB = (size_t)HALF * g.ldb * 2;
    const size_t tstepB = 2 * hstepB; const long rowbA = (long)g.lda * 2;
    const unsigned ldsw = (unsigned)wid * 1024u;
    const int aoff = lds_byte(wr * 64 + fr, fq * 8), boff = lds_byte(wc * 32 + fr, fq * 8);
#define PG8_SA(b, h) (((b) * 2 + (h)) * HTB)
#define PG8_SB(b, h) ((4 + (b) * 2 + (h)) * HTB)
#define PG8_STAGE(bufoff, gbase, voff) do { _Pragma("unroll") for (int _i = 0; _i < 2; ++_i) \
        __builtin_amdgcn_global_load_lds((const unsigned*)((const char*)(gbase) + (voff)[_i]), (LAS unsigned*)(lds + (bufoff) + ldsw + _i * 8192), 16, 0, 0); } while (0)
#define PG8_LDA(dst, b, h) do { _Pragma("unroll") for (int m = 0; m < 4; ++m) _Pragma("unroll") for (int k = 0; k < 2; ++k) dst[m][k] = *(const LAS bf16x8*)(lds + PG8_SA(b, h) + aoff + m * 2048 + k * 1024); } while (0)
#define PG8_LDB(dst, b, h) do { _Pragma("unroll") for (int n = 0; n < 2; ++n) _Pragma("unroll") for (int k = 0; k < 2; ++k) dst[n][k] = *(const LAS bf16x8*)(lds + PG8_SB(b, h) + boff + n * 2048 + k * 1024); } while (0)
#define PG8_MMA(ai, bj, At, Bt) do { __builtin_amdgcn_s_setprio(1); _Pragma("unroll") for (int m = 0; m < 4; ++m) _Pragma("unroll") for (int n = 0; n < 2; ++n) _Pragma("unroll") for (int k = 0; k < 2; ++k) \
        acc[ai][bj][m][n] = __builtin_amdgcn_mfma_f32_16x16x32_bf16(Bt[n][k], At[m][k], acc[ai][bj][m][n], 0, 0, 0); __builtin_amdgcn_s_setprio(0); } while (0)
#define PG8_WAIT_V(n) asm volatile("s_waitcnt vmcnt(" #n ")" ::: "memory")
#define PG8_WAIT_L(n) asm volatile("s_waitcnt lgkmcnt(" #n ")" ::: "memory")
#define PG8_BAR __builtin_amdgcn_s_barrier()
#define PG8_SCHED __builtin_amdgcn_sched_barrier(0)
    Unit cur, nxt; int ui = 0;
    if (!S.next(0, cur)) return;
    f32x4 acc[2][2][4][2];
#pragma unroll
    for (int a = 0; a < 2; ++a)
#pragma unroll
        for (int b = 0; b < 2; ++b)
#pragma unroll
            for (int m = 0; m < 4; ++m)
#pragma unroll
                for (int n = 0; n < 2; ++n) acc[a][b][m][n] = (f32x4){0.f, 0.f, 0.f, 0.f};
    bf16x8 At[4][2], B0[2][2], B1[2][2];
    const char* cA = (const char*)g.A + S.arow(cur) * rowbA; const char* cB = (const char*)g.Bt + (size_t)cur.pn * tstepB;
    PG8_STAGE(PG8_SB(0, 0), cB, voffB); PG8_STAGE(PG8_SB(0, 1), cB + hstepB, voffB); PG8_STAGE(PG8_SA(0, 0), cA, voffA); PG8_STAGE(PG8_SA(0, 1), cA + hstepA, voffA);
    if (wr == 1) PG8_BAR;
    PG8_WAIT_V(2); PG8_BAR;
    PG8_STAGE(PG8_SB(1, 0), cB + kstep, voffB); PG8_STAGE(PG8_SA(1, 0), cA + kstep, voffA); PG8_STAGE(PG8_SB(1, 1), cB + hstepB + kstep, voffB);
    PG8_WAIT_V(6); PG8_BAR;
    for (;;) {
        const bool has_next = S.next(ui + 1, nxt);
        const char* nA = has_next ? (const char*)g.A + S.arow(nxt) * rowbA : cA; const char* nB = has_next ? (const char*)g.Bt + (size_t)nxt.pn * tstepB : cB;
        for (int t = 0; t < nt; t += 2) {
            const bool last = (t == nt - 2);
            const char* a1 = cA + (size_t)(t + 1) * kstep;
            const char* a2 = last ? nA : cA + (size_t)(t + 2) * kstep; const char* b2 = last ? nB : cB + (size_t)(t + 2) * kstep;
            const char* a3 = a2 + kstep; const char* b3 = b2 + kstep;
            PG8_LDB(B0, 0, 0); PG8_LDB(B1, 0, 1); PG8_SCHED; PG8_LDA(At, 0, 0); PG8_STAGE(PG8_SA(1, 1), a1 + hstepA, voffA);
            PG8_WAIT_V(8); PG8_WAIT_L(0); PG8_BAR; PG8_MMA(0, 0, At, B0); PG8_MMA(0, 1, At, B1); PG8_BAR; PG8_SCHED;
            PG8_LDA(At, 0, 1); PG8_STAGE(PG8_SB(0, 0), b2, voffB); PG8_STAGE(PG8_SB(0, 1), b2 + hstepB, voffB); PG8_STAGE(PG8_SA(0, 0), a2, voffA);
            PG8_WAIT_V(8); PG8_WAIT_L(0); PG8_BAR; PG8_MMA(1, 0, At, B0); PG8_MMA(1, 1, At, B1); PG8_BAR; PG8_SCHED;
            PG8_LDB(B0, 1, 0); PG8_LDB(B1, 1, 1); PG8_SCHED; PG8_LDA(At, 1, 0); PG8_STAGE(PG8_SA(0, 1), a2 + hstepA, voffA);
            PG8_WAIT_V(8); PG8_WAIT_L(0); PG8_BAR; PG8_MMA(0, 0, At, B0); PG8_MMA(0, 1, At, B1); PG8_BAR; PG8_SCHED;
            PG8_LDA(At, 1, 1); PG8_STAGE(PG8_SB(1, 0), b3, voffB); PG8_STAGE(PG8_SB(1, 1), b3 + hstepB, voffB); PG8_STAGE(PG8_SA(1, 0), a3, voffA);
            PG8_WAIT_V(8); PG8_WAIT_L(0); PG8_BAR; PG8_MMA(1, 0, At, B0); PG8_MMA(1, 1, At, B1); PG8_BAR; PG8_SCHED;
        }
        if (wr == 0) PG8_BAR;
        E(acc, cur, wr, wc, fr, fq);
        if (!has_next) break;
#pragma unroll
        for (int a = 0; a < 2; ++a)
#pragma unroll
            for (int b = 0; b < 2; ++b)
#pragma unroll
                for (int m = 0; m < 4; ++m)
#pragma unroll
                    for (int n = 0; n < 2; ++n) acc[a][b][m][n] = (f32x4){0.f, 0.f, 0.f, 0.f};
        cur = nxt; cA = nA; cB = nB; ++ui;
        if (wr == 1) PG8_BAR;
    }
    PG8_WAIT_V(0);
    PG8_BAR;
#undef PG8_SA
#undef PG8_SB
#undef PG8_STAGE
#undef PG8_LDA
#undef PG8_LDB
#undef PG8_MMA
#undef PG8_WAIT_V
#undef PG8_WAIT_L
#undef PG8_BAR
#undef PG8_SCHED
}
}

struct EpiPlain {
    static constexpr bool PERM = true;
    bf16_t* O; bf16_t* O2; int ldc; int split;
    __device__ __forceinline__ void operator()(const f32x4 (&acc)[2][2][4][2], const pg8::Unit& u, int wr, int wc, int fr, int fq) const {
        bf16_t* base = (u.pn < split) ? O + u.pn * 256 : O2 + (u.pn - split) * 256;
        const int row0 = u.pm * 256 + wr * 64 + fr, col0 = wc * 32 + 8 * fq;
#pragma unroll
        for (int ai = 0; ai < 2; ++ai)
#pragma unroll
            for (int m = 0; m < 4; ++m) { bf16_t* rowp = base + (size_t)(row0 + ai * 128 + m * 16) * ldc + col0;
#pragma unroll
                for (int bj = 0; bj < 2; ++bj) { const f32x4 v0 = acc[ai][bj][m][0], v1 = acc[ai][bj][m][1];
                    u32x4 w; w.x = cvt_pk_bf16(v0[0], v0[1]); w.y = cvt_pk_bf16(v0[2], v0[3]); w.z = cvt_pk_bf16(v1[0], v1[1]); w.w = cvt_pk_bf16(v1[2], v1[3]);
                    *(GAS u32x4*)(rowp + bj * 128) = w; } }
    }
};
struct EpiRes {
    static constexpr bool PERM = true;
    bf16_t* xb; float* ssp;
    __device__ __forceinline__ void operator()(const f32x4 (&acc)[2][2][4][2], const pg8::Unit& u, int wr, int wc, int fr, int fq) const {
        const int row0 = u.pm * 256 + wr * 64 + fr, col0 = u.pn * 256 + wc * 32 + 8 * fq;
        u32x4 xo[2][4][2];
#pragma unroll
        for (int ai = 0; ai < 2; ++ai)
#pragma unroll
            for (int m = 0; m < 4; ++m)
#pragma unroll
                for (int bj = 0; bj < 2; ++bj) xo[ai][m][bj] = *(const GAS u32x4*)(xb + (size_t)(row0 + ai * 128 + m * 16) * DM + col0 + bj * 128);
        __builtin_amdgcn_sched_barrier(0);
#pragma unroll
        for (int ai = 0; ai < 2; ++ai)
#pragma unroll
            for (int m = 0; m < 4; ++m) { const int row = row0 + ai * 128 + m * 16; const size_t off = (size_t)row * DM + col0; float ss = 0.f;
#pragma unroll
                for (int bj = 0; bj < 2; ++bj) { const u32x4 bw = xo[ai][m][bj]; const f32x4 a0 = acc[ai][bj][m][0], a1 = acc[ai][bj][m][1];
                    u32x4 w; w.x = cvt_pk_bf16(bflo(bw.x) + a0[0], bfhi(bw.x) + a0[1]); w.y = cvt_pk_bf16(bflo(bw.y) + a0[2], bfhi(bw.y) + a0[3]);
                    w.z = cvt_pk_bf16(bflo(bw.z) + a1[0], bfhi(bw.z) + a1[1]); w.w = cvt_pk_bf16(bflo(bw.w) + a1[2], bfhi(bw.w) + a1[3]);
                    *(GAS u32x4*)(xb + off + bj * 128) = w;
#pragma unroll
                    for (int e = 0; e < 4; ++e) { const float v0 = bflo(w[e]), v1 = bfhi(w[e]); ss += v0 * v0 + v1 * v1; } }
                ss = xsum32(xsum16(ss));
                if (fq == 0) ((GAS float*)ssp)[(size_t)row * 16 + u.pn * 4 + wc] = ss; }
    }
};
__device__ __forceinline__ float row_rstd(const float* ssp, long row) {
    const GAS f32x4* sp = (const GAS f32x4*)(ssp + row * 16); const f32x4 s0 = sp[0], s1 = sp[1], s2 = sp[2], s3 = sp[3];
    const float ss = ((s0[0] + s0[1]) + (s0[2] + s0[3])) + ((s1[0] + s1[1]) + (s1[2] + s1[3])) + ((s2[0] + s2[1]) + (s2[2] + s2[3])) + ((s3[0] + s3[1]) + (s3[2] + s3[3]));
    return __builtin_amdgcn_rsqf(ss * (1.f / DM) + EPS);
}
__device__ __forceinline__ float row_rstd_q(const float* ssp, long row, int fq) {
    const f32x4 s = ((const GAS f32x4*)(ssp + row * 16))[fq];
    const float ss = xsum32(xsum16((s[0] + s[1]) + (s[2] + s[3])));
    return __builtin_amdgcn_rsqf(ss * (1.f / DM) + EPS);
}
__device__ __forceinline__ float rstd_from_q(const f32x4 s) { const float ss = xsum32(xsum16((s[0] + s[1]) + (s[2] + s[3]))); return __builtin_amdgcn_rsqf(ss * (1.f / DM) + EPS); }
template <int SH> __device__ __forceinline__ float row_shift(float cur, float prv) {
    const int t = __builtin_amdgcn_mov_dpp(__builtin_bit_cast(int, prv), 0x120 + SH, 0xf, 0xf, false);
    const int r = __builtin_amdgcn_update_dpp(t, __builtin_bit_cast(int, cur), 0x110 + SH, 0xf, 0xf, false);
    return __builtin_bit_cast(float, r);
}
template <int SH> __device__ __forceinline__ float row_shift0(float cur) {
    return __builtin_bit_cast(float, __builtin_amdgcn_update_dpp(0, __builtin_bit_cast(int, cur), 0x110 + SH, 0xf, 0xf, true));
}
struct EpiGlu {
    static constexpr bool PERM = true;
    bf16_t* G; const float* ssp; const float* cw; const float* cb;
    __device__ __forceinline__ void operator()(const f32x4 (&acc)[2][2][4][2], const pg8::Unit& u, int wr, int wc, int fr, int fq) const {
        const int b = u.pm / 17, jj = u.pm % 17, ch0 = 128 * u.pn + 32 * wc + 8 * fq;
        f32x4 w0[2], w1[2], w2[2], bi[2];
#pragma unroll
        for (int n = 0; n < 2; ++n) { w0[n] = *(const GAS f32x4*)(cw + ch0 + 4 * n); w1[n] = *(const GAS f32x4*)(cw + FF + ch0 + 4 * n); w2[n] = *(const GAS f32x4*)(cw + 2 * FF + ch0 + 4 * n); bi[n] = *(const GAS f32x4*)(cb + ch0 + 4 * n); }
        float rsa[2][4];
        { f32x4 pq[8];
#pragma unroll
          for (int k = 0; k < 8; ++k) { const int t = 248 * jj + 62 * (2 * (k >> 2) + wr) - 2 + 4 * fr + (k & 3); const long grow = (long)b * SEQ + t;
              pq[k] = ((const GAS f32x4*)(ssp + (size_t)(t < 0 ? (long)b * SEQ : (grow < MTOK ? grow : MTOK - 1)) * 16))[fq]; }
          __builtin_amdgcn_sched_barrier(0);
#pragma unroll
          for (int k = 0; k < 8; ++k) { const int t = 248 * jj + 62 * (2 * (k >> 2) + wr) - 2 + 4 * fr + (k & 3); const float r_ = rstd_from_q(pq[k]); rsa[k >> 2][k & 3] = (t >= 0) ? r_ : 0.f; } }
#pragma unroll
        for (int ai = 0; ai < 2; ++ai) {
            const int t0 = 248 * jj + 62 * (2 * ai + wr) - 2 + 4 * fr;
            float rs[4];
#pragma unroll
            for (int m = 0; m < 4; ++m) rs[m] = rsa[ai][m];
            u32x2 gp[4];
#pragma unroll
            for (int n = 0; n < 2; ++n) {
                f32x4 av[4];
#pragma unroll
                for (int m = 0; m < 4; ++m) { av[m] = acc[ai][0][m][n] * rs[m];
                    if (ai == 0 && m < 2) { if (t0 + m < 0) av[m] = (f32x4){0.f, 0.f, 0.f, 0.f}; } }
                f32x4 s3, s2;
#pragma unroll
                for (int e = 0; e < 4; ++e) { s3[e] = row_shift0<1>(av[3][e]); s2[e] = row_shift0<1>(av[2][e]); }
#pragma unroll
                for (int m = 0; m < 4; ++m) {
                    const f32x4 a1 = m == 0 ? s3 : av[m == 0 ? 0 : m - 1], a2 = m == 0 ? s2 : m == 1 ? s3 : av[m < 2 ? 0 : m - 2];
                    f32x4 gv;
#pragma unroll
                    for (int e = 0; e < 4; ++e) {
                        const float cv = __builtin_fmaf(w2[n][e], av[m][e], __builtin_fmaf(w1[n][e], a1[e], __builtin_fmaf(w0[n][e], a2[e], bi[n][e])));
                        gv[e] = (cv * __builtin_amdgcn_rcpf(1.0f + fexp2(cv * -LOG2E))) * (acc[ai][1][m][n][e] * rs[m]); }
                    if (n == 0) { gp[m].x = cvt_pk_bf16(gv[0], gv[1]); gp[m].y = cvt_pk_bf16(gv[2], gv[3]); }
                    else { const int t = t0 + m;
                        if ((fr > 0 || m >= 2) && t < SEQ) { u32x4 w; w.x = gp[m].x; w.y = gp[m].y; w.z = cvt_pk_bf16(gv[0], gv[1]); w.w = cvt_pk_bf16(gv[2], gv[3]);
                            *(GAS u32x4*)(G + (size_t)((long)b * SEQ + t) * FF + ch0) = w; } }
                }
            }
        }
    }
};
struct EpiIn {
    static constexpr bool PERM = true;
    int kind;
    unsigned char* ws;
    const float* ssp;
    __device__ __forceinline__ void operator()(f32x4 (&acc)[2][2][4][2], const pg8::Unit& u, int wr, int wc, int fr, int fq) const {
        bf16_t* dst; int ld; int mode = 0; const int pn = u.pn;
        if (kind == 0) {
            if (pn < 8) { dst = (bf16_t*)(ws + WS_OA) + pn * 256; ld = LDOA; }
            else if (pn == 8) { dst = (bf16_t*)(ws + WS_QR); ld = 256; mode = 3; }
            else if (pn == 9) { dst = (bf16_t*)(ws + WS_CKV); ld = CKVP; }
            else if (pn == 10) { dst = (bf16_t*)(ws + WS_CKV) + 256; ld = CKVP; mode = 4; }
            else if (pn < 15) { dst = (bf16_t*)(ws + WS_QI) + (pn - 11) * 256; ld = 1024; mode = 2; }
            else { dst = (bf16_t*)(ws + WS_OA) + 2048; ld = LDOA; }
        } else if (kind == 1) {
            if (pn < 4) { dst = (bf16_t*)(ws + WS_OB) + pn * 256; ld = LDOB; mode = 2; }
            else if (pn == 4) { dst = (bf16_t*)(ws + WS_KB); ld = 256; mode = 2; }
            else if (pn == 5) { dst = (bf16_t*)(ws + WS_VB); ld = 256; }
            else { dst = (bf16_t*)(ws + WS_OB) + 1024; ld = LDOB; }
        } else {
            if (pn < 4) { dst = (bf16_t*)(ws + WS_OC) + pn * 256; ld = LDOB; mode = 1; }
            else if (pn < 8) { dst = (bf16_t*)(ws + WS_KC) + (pn - 4) * 256; ld = 1024; mode = 1; }
            else if (pn < 12) { dst = (bf16_t*)(ws + WS_VC) + (pn - 8) * 256; ld = 1024; }
            else { dst = (bf16_t*)(ws + WS_OC) + 1024; ld = LDOB; }
        }
        const int row0 = u.pm * 256 + wr * 64 + fr;
        { f32x4 pq[8];
#pragma unroll
          for (int k = 0; k < 8; ++k) pq[k] = ((const GAS f32x4*)(ssp + (size_t)(row0 + (k >> 2) * 128 + (k & 3) * 16) * 16))[fq];
          __builtin_amdgcn_sched_barrier(0);
#pragma unroll
          for (int k = 0; k < 8; ++k) { const float rs = rstd_from_q(pq[k]);
#pragma unroll
              for (int bj = 0; bj < 2; ++bj)
#pragma unroll
                  for (int n = 0; n < 2; ++n) acc[k >> 2][bj][k & 3][n] *= rs; } }
        const bool r32 = (mode == 1 && wc == 0) || mode == 3 || (mode == 4 && wc == 0);
        const bool r16 = (mode == 2 && (wc & 1) == 0) || (mode == 4 && wc == 1);
        if (r32 || r16) {
            const int xl = r32 ? 32 : 16;
            const bool second = r32 ? (fq >= 2) : (fq & 1);
            const float* ct = (const float*)(ws + (r32 ? WS_COS32 : WS_COS16)); const float* st = (const float*)(ws + (r32 ? WS_SIN32 : WS_SIN16));
            const int tw = r32 ? 16 : 8, i0 = r32 ? 8 * (fq & 1) : 0;
            const int nbj = (mode == 4) ? 1 : 2;
#define EI_TAB(k_, c0_, c1_, s0_, s1_) do { const int row_ = row0 + ((k_) >> 2) * 128 + ((k_) & 3) * 16; \
                c0_ = *(const GAS f32x4*)(ct + (size_t)row_ * tw + i0); c1_ = *(const GAS f32x4*)(ct + (size_t)row_ * tw + i0 + 4); \
                s0_ = *(const GAS f32x4*)(st + (size_t)row_ * tw + i0); s1_ = *(const GAS f32x4*)(st + (size_t)row_ * tw + i0 + 4); } while (0)
            f32x4 nc0, nc1, ns0, ns1; EI_TAB(0, nc0, nc1, ns0, ns1);
            const bool act = r32 ? true : (fq < 2);
#pragma unroll
            for (int k = 0; k < 8; ++k) {
                const f32x4 c0 = nc0, c1 = nc1, s0 = ns0, s1 = ns1;
                if (k < 7) { EI_TAB(k + 1, nc0, nc1, ns0, ns1); }
                __builtin_amdgcn_sched_barrier(0);
                const int ai = k >> 2, m = k & 3;
#pragma unroll
                for (int bj = 0; bj < 2; ++bj) { if (bj < nbj) {
#pragma unroll
                    for (int n = 0; n < 2; ++n) { f32x4 v = acc[ai][bj][m][n]; const f32x4 cc = n ? c1 : c0, ss = n ? s1 : s0; f32x4 o;
#pragma unroll
                        for (int e = 0; e < 4; ++e) { const float p = __shfl_xor(v[e], xl); o[e] = second ? (v[e] * cc[e] + p * ss[e]) : (v[e] * cc[e] - p * ss[e]); }
                        if (act) acc[ai][bj][m][n] = o; } } }
            }
#undef EI_TAB
        }
        if (mode != 4) {
            const int col0 = wc * 32 + 8 * fq;
#pragma unroll
            for (int ai = 0; ai < 2; ++ai)
#pragma unroll
                for (int m = 0; m < 4; ++m) { bf16_t* rowp = dst + (size_t)(row0 + ai * 128 + m * 16) * ld + col0;
#pragma unroll
                    for (int bj = 0; bj < 2; ++bj) { const f32x4 v0 = acc[ai][bj][m][0], v1 = acc[ai][bj][m][1];
                        u32x4 w; w.x = cvt_pk_bf16(v0[0], v0[1]); w.y = cvt_pk_bf16(v0[2], v0[3]); w.z = cvt_pk_bf16(v1[0], v1[1]); w.w = cvt_pk_bf16(v1[2], v1[3]);
                        *(GAS u32x4*)(rowp + bj * 128) = w; } }
        } else {
            bf16_t* KI = (bf16_t*)(ws + WS_KI); float* WI = (float*)(ws + WS_WI);
#pragma unroll
            for (int ai = 0; ai < 2; ++ai)
#pragma unroll
                for (int m = 0; m < 4; ++m) { const size_t row = (size_t)(row0 + ai * 128 + m * 16); const f32x4 v0 = acc[ai][0][m][0], v1 = acc[ai][0][m][1];
                    u32x4 w; w.x = cvt_pk_bf16(v0[0], v0[1]); w.y = cvt_pk_bf16(v0[2], v0[3]); w.z = cvt_pk_bf16(v1[0], v1[1]); w.w = cvt_pk_bf16(v1[2], v1[3]);
                    if (wc == 0) *(GAS u32x4*)(dst + row * CKVP + 8 * fq) = w;
                    else if (wc < 3) *(GAS u32x4*)(KI + row * 64 + (wc - 1) * 32 + 8 * fq) = w;
                    else if (fq < 2) { *(GAS f32x4*)(WI + row * 16 + 8 * fq) = v0 * 0.03125f; *(GAS f32x4*)(WI + row * 16 + 8 * fq + 4) = v1 * 0.03125f; } }
        }
    }
};

struct Args {
    const float* x; const float* mem; const int* positions;
    const float* g_mix; const float* g_ffn; const float* g_mem; const float* g_final; const float* w_mem_kv;
    const float* a_w_in; const float* a_kv_norm; const float* a_w_uk; const float* a_w_uv; const float* a_w_out;
    const float* b_w_in; const float* b_sinks; const float* b_w_out; const float* c_w_in; const float* c_w_out;
    const float* f_w_up; const float* f_conv_w; const float* f_conv_b; const float* f_w_down;
    float* out; unsigned char* ws;
    int ph_lo, ph_hi;
};

template <class T> __device__ __forceinline__ T* gptr(T* p) { return (T*)(GAS T*)p; }
typedef const __attribute__((address_space(4))) Args* ArgP;
__device__ __forceinline__ ArgP argp() { ArgP p = (ArgP)__builtin_amdgcn_kernarg_segment_ptr(); asm volatile("" : "+s"(p)); return p; }
struct Ctx { LAS unsigned char* lds; int tid, lane, wave, vcu, G, gw, NGW; };
__device__ __forceinline__ int lane_id() { int l; asm volatile("v_mbcnt_lo_u32_b32 %0, -1, 0\n\tv_mbcnt_hi_u32_b32 %0, -1, %0" : "=v"(l)); return l; }
__device__ __forceinline__ Ctx launder(Ctx c) { int l = lane_id(); asm volatile("" : "+v"(l)); c.lane = l; c.tid = c.wave * 64 + l;
    asm volatile("" : "+s"(c.wave), "+s"(c.vcu), "+s"(c.gw)); return c; }

__device__ __forceinline__ void transpose_job(const Ctx& c, int& base, const float* W, int ldw, int k_org, int n_org, int Ksub, int Nsub, bf16_t* WT, int ldt, int koff, const float* gain = nullptr) {
    LAS float* scr = (LAS float*)(c.lds + c.wave * 16384);
    const int nblk = Nsub / 32, nitems = (Ksub / 64) * nblk, lane = c.lane;
    int start = (c.gw - (base % c.NGW) + c.NGW) % c.NGW; base += nitems;
    if (start >= nitems) return;
    const int ch = lane & 7;
    float v[32]; f32x4 g0 = {1.f, 1.f, 1.f, 1.f}, g1 = {1.f, 1.f, 1.f, 1.f};
#define TJ_LOAD(it_) do { const int kb_ = (it_) / nblk, nb_ = (it_) % nblk; const float* wp_ = W + (size_t)(k_org + 64 * kb_ + (lane >> 5)) * ldw + n_org + 32 * nb_ + (lane & 31); \
        _Pragma("unroll") for (int i = 0; i < 32; ++i) v[i] = ((const GAS float*)wp_)[(size_t)(2 * i) * ldw]; \
        if (gain) { g0 = *(const GAS f32x4*)(gain + k_org + 64 * kb_ + 8 * ch); g1 = *(const GAS f32x4*)(gain + k_org + 64 * kb_ + 8 * ch + 4); } } while (0)
    TJ_LOAD(start);
    for (int it = start; it < nitems; it += c.NGW) {
        const int kb = it / nblk, nb = it % nblk, k0 = 64 * kb, n0 = 32 * nb;
#pragma unroll
        for (int i = 0; i < 32; ++i) scr[(2 * i + (lane >> 5)) * 33 + (lane & 31)] = v[i];
        const f32x4 h0 = g0, h1 = g1;
        asm volatile("s_waitcnt lgkmcnt(0)" ::: "memory");
        if (it + c.NGW < nitems) { TJ_LOAD(it + c.NGW); }
#pragma unroll
        for (int j = 0; j < 4; ++j) { const int n = (lane >> 3) + 8 * j; const LAS float* sp = scr + (8 * ch) * 33 + n;
            u32x4 o; o.x = cvt_pk_bf16(sp[0 * 33] * h0[0], sp[1 * 33] * h0[1]); o.y = cvt_pk_bf16(sp[2 * 33] * h0[2], sp[3 * 33] * h0[3]); o.z = cvt_pk_bf16(sp[4 * 33] * h1[0], sp[5 * 33] * h1[1]); o.w = cvt_pk_bf16(sp[6 * 33] * h1[2], sp[7 * 33] * h1[3]);
            *(GAS u32x4*)(WT + (size_t)(n0 + n) * ldt + koff + k0 + 8 * ch) = o; }
        asm volatile("s_waitcnt lgkmcnt(0)" ::: "memory");
    }
#undef TJ_LOAD
}
__device__ __forceinline__ void rms_row_bf16(const float* xrow, const float* gain, bf16_t* orow, int lane) {
    const f32x4* xr = (const f32x4*)xrow + lane; const f32x4* gr = (const f32x4*)gain + lane;
    f32x4 v[4]; float s = 0.f;
#pragma unroll
    for (int j = 0; j < 4; ++j) { v[j] = xr[64 * j]; s += (v[j].x * v[j].x + v[j].y * v[j].y) + (v[j].z * v[j].z + v[j].w * v[j].w); }
    const float rstd = 1.0f / sqrtf(wave_sum(s) * (1.f / DM) + EPS);
    u32x2* o8 = (u32x2*)orow + lane;
#pragma unroll
    for (int j = 0; j < 4; ++j) { const f32x4 gg = gr[64 * j]; u32x2 w; w.x = cvt_pk_bf16(v[j].x * rstd * gg.x, v[j].y * rstd * gg.y); w.y = cvt_pk_bf16(v[j].z * rstd * gg.z, v[j].w * rstd * gg.w); o8[64 * j] = w; }
}
__device__ __forceinline__ void rms_rows_phase(const Ctx& c0, const float* x, const float* gain, bf16_t* xn, int nrows) {
    const Ctx c = launder(c0);
    for (int m = c.gw; m < nrows; m += c.NGW) rms_row_bf16(x + (size_t)m * DM, gain, xn + (size_t)m * DM, c.lane);
}
__device__ __forceinline__ void final_norm_phase(const Ctx& c0, const bf16_t* xb, const float* ssp, const float* gain, float* out) {
    const Ctx c = launder(c0);
    f32x4 gg[4];
#pragma unroll
    for (int j = 0; j < 4; ++j) gg[j] = ((const GAS f32x4*)gain + c.lane)[64 * j];
    for (int m = c.gw; m < MTOK; m += c.NGW) {
        const GAS u32x2* xr = (const GAS u32x2*)(xb + (size_t)m * DM) + c.lane; f32x4* o = (f32x4*)(out + (size_t)m * DM) + c.lane;
        u32x2 w[4];
#pragma unroll
        for (int j = 0; j < 4; ++j) w[j] = xr[64 * j];
        const float rstd = row_rstd(ssp, m);
#pragma unroll
        for (int j = 0; j < 4; ++j) o[64 * j] = (f32x4){bflo(w[j].x) * rstd * gg[j].x, bfhi(w[j].x) * rstd * gg[j].y, bflo(w[j].y) * rstd * gg[j].z, bfhi(w[j].y) * rstd * gg[j].w};
    }
}
__device__ __forceinline__ void prologue1(const Ctx& c0) {
    const Ctx c = launder(c0);
    ArgP ap = argp();
#define a (*ap)
    unsigned char* ws = gptr(a.ws);
    const int gt = c.gw * 64 + c.lane, NGT = c.NGW * 64;
    int base = 0;
#pragma nounroll
    for (int l = 0; l < DEPTH; ++l) {
        const int kind = l % 3, j = l / 3;
        unsigned char* wl = ws + WS_WT + (size_t)l * WT_LAYER;
        const float* gm = gptr(a.g_mix) + (size_t)l * DM; const float* gf = gptr(a.g_ffn) + (size_t)l * DM;
#pragma nounroll
        for (int pn = 0; pn < 22; ++pn) {
            transpose_job(c, base, gptr(a.f_w_up) + (size_t)l * DM * 2 * FF, 2 * FF, 0, 128 * pn, DM, 128, (bf16_t*)(wl + WT_UP) + (size_t)(256 * pn) * DM, DM, 0, gf);
            transpose_job(c, base, gptr(a.f_w_up) + (size_t)l * DM * 2 * FF, 2 * FF, 0, FF + 128 * pn, DM, 128, (bf16_t*)(wl + WT_UP) + (size_t)(256 * pn + 128) * DM, DM, 0, gf);
        }
        transpose_job(c, base, gptr(a.f_w_down) + (size_t)l * FF * DM, DM, 0, 0, FF, DM, (bf16_t*)(wl + WT_DOWN), FF, 0);
        transpose_job(c, base, gptr(a.w_mem_kv) + (size_t)l * DM * 512, 512, 0, 0, DM, 512, (bf16_t*)(wl + WT_MKV), DM, 0);
        if (kind == 1) {
            transpose_job(c, base, gptr(a.b_w_out), DM, 0, 0, 1280, DM, (bf16_t*)(wl + WT_OUT), 1280, 0);
            transpose_job(c, base, gptr(a.b_w_in), NB_IN, 0, 0, DM, NB_IN, (bf16_t*)(wl + WT_IN), DM, 0, gm);
        } else if (kind == 2) {
            transpose_job(c, base, gptr(a.c_w_out), DM, 0, 0, 1280, DM, (bf16_t*)(wl + WT_OUT), 1280, 0);
            transpose_job(c, base, gptr(a.c_w_in), NC_IN, 0, 0, DM, NC_IN, (bf16_t*)(wl + WT_IN), DM, 0, gm);
        } else {
            const float* win = gptr(a.a_w_in) + (size_t)j * DM * 2672; const float* wout = gptr(a.a_w_out) + (size_t)j * 1280 * DM;
            unsigned char* tmp = ws + WS_TMP + (size_t)j * TMP_STRIDE;
            bf16_t* wit = (bf16_t*)(wl + WT_IN);
            transpose_job(c, base, wout, DM, 0, 0, 1280, DM, (bf16_t*)(tmp + TMP_WOT), 1280, 0);
            transpose_job(c, base, wout, DM, 1024, 0, 256, DM, (bf16_t*)(wl + WT_OUT), LDOA, 2048);
#pragma nounroll
            for (int h = 0; h < 8; ++h) transpose_job(c, base, win, 2672, 0, h * 128, DM, 32, wit + (size_t)(2048 + 32 * h) * DM, DM, 0, gm);
            transpose_job(c, base, win, 2672, 0, 1024, DM, 256, wit + (size_t)2304 * DM, DM, 0, gm);
            transpose_job(c, base, win, 2672, 0, 1280, DM, 32, wit + (size_t)2560 * DM, DM, 0, gm);
            transpose_job(c, base, win, 2672, 0, 2336, DM, 96, wit + (size_t)2592 * DM, DM, 0, gm);
            transpose_job(c, base, win, 2672, 0, 1312, DM, 1024, wit + (size_t)2816 * DM, DM, 0, gm);
            transpose_job(c, base, win, 2672, 0, 2416, DM, 256, wit + (size_t)3840 * DM, DM, 0, gm);
            { u32x4* z = (u32x4*)(wit + (size_t)2688 * DM); for (int i = gt; i < 128 * DM / 8; i += NGT) z[i] = (u32x4){0u, 0u, 0u, 0u}; }
            { const GAS f32x4* s = (const GAS f32x4*)win; u32x2* d = (u32x2*)(tmp + TMP_WNAT); constexpr int NQ = DM * 2672 / 4;
              for (int i0 = gt; i0 < NQ; i0 += 3 * NGT) { f32x4 v[3]; float g[3];
#pragma unroll
                  for (int u = 0; u < 3; ++u) { const int i = i0 + u * NGT < NQ ? i0 + u * NGT : i0; v[u] = s[i]; g[u] = ((const GAS float*)gm)[i / 668]; }
#pragma unroll
                  for (int u = 0; u < 3; ++u) { const int i = i0 + u * NGT; if (i < NQ) { const f32x4 q = v[u] * g[u]; u32x2 w; w.x = cvt_pk_bf16(q.x, q.y); w.y = cvt_pk_bf16(q.z, q.w); d[i] = w; } } } }
            { const GAS f32x4* s = (const GAS f32x4*)(gptr(a.a_w_uv) + (size_t)j * 256 * 1024); u32x2* d = (u32x2*)(tmp + TMP_WUVN); constexpr int NQ = 256 * 1024 / 4;
              for (int i0 = gt; i0 < NQ; i0 += 2 * NGT) { f32x4 v[2];
#pragma unroll
                  for (int u = 0; u < 2; ++u) { const int i = i0 + u * NGT < NQ ? i0 + u * NGT : i0; v[u] = s[i]; }
#pragma unroll
                  for (int u = 0; u < 2; ++u) { const int i = i0 + u * NGT; if (i < NQ) { u32x2 w; w.x = cvt_pk_bf16(v[u].x, v[u].y); w.y = cvt_pk_bf16(v[u].z, v[u].w); d[i] = w; } } } }
            { const float* s = gptr(a.a_w_uk) + (size_t)j * 256 * 8 * 96; bf16_t* d = (bf16_t*)(tmp + TMP_WUKT);
              for (int i = gt; i < 8 * 256 * 128; i += NGT) { const int n = i & 127, r = (i >> 7) & 255, h = i >> 15; d[i] = (bf16_t)(n < 96 ? f2bf(s[((size_t)r * 8 + h) * 96 + n]) : 0u); } }
        }
    }
    { float* c32 = (float*)(ws + WS_COS32); float* s32 = (float*)(ws + WS_SIN32); float* c16 = (float*)(ws + WS_COS16); float* s16 = (float*)(ws + WS_SIN16);
      for (int i = gt; i < MTOK * 24; i += NGT) { const int row = i / 24, k = i % 24; const float pos = (float)gptr(a.positions)[row];
          const float ex = (k < 16) ? (float)k * (-1.0f / 16.0f) : (float)(k - 16) * (-1.0f / 8.0f); const float inv = exp2f(ex * 18.931568569324174f); const float ang = pos * inv;
          const double ad = (double)ang; const double kk = rint(ad * 0.15915494309189535); const float r = (float)(ad - kk * 6.283185307179586);
          const float cs = __cosf(r), sn = __sinf(r);
          if (k < 16) { c32[row * 16 + k] = cs; s32[row * 16 + k] = sn; } else { c16[row * 8 + k - 16] = cs; s16[row * 8 + k - 16] = sn; } } }
    rms_rows_phase(c, gptr(a.mem), gptr(a.g_mem), (bf16_t*)(ws + WS_MEMN), BATCH * MEMLEN);
    { bf16_t* xb = (bf16_t*)(ws + WS_XN); float* ssp = (float*)(ws + WS_SSP);
      for (int m0 = c.gw; m0 < MTOK; m0 += 2 * c.NGW) {
          f32x4 v[2][4];
#pragma unroll
          for (int r = 0; r < 2; ++r) { const int m = m0 + r * c.NGW < MTOK ? m0 + r * c.NGW : m0; const GAS f32x4* xr = (const GAS f32x4*)(gptr(a.x) + (size_t)m * DM) + c.lane;
#pragma unroll
              for (int jq = 0; jq < 4; ++jq) v[r][jq] = xr[64 * jq]; }
          __builtin_amdgcn_sched_barrier(0);
#pragma unroll
          for (int r = 0; r < 2; ++r) { const int m = m0 + r * c.NGW; if (m < MTOK) { u32x2* o8 = (u32x2*)(xb + (size_t)m * DM) + c.lane; float s2 = 0.f;
#pragma unroll
              for (int jq = 0; jq < 4; ++jq) { const f32x4 q = v[r][jq]; s2 += (q.x * q.x + q.y * q.y) + (q.z * q.z + q.w * q.w); u32x2 w; w.x = cvt_pk_bf16(q.x, q.y); w.y = cvt_pk_bf16(q.z, q.w); o8[64 * jq] = w; }
              s2 = wave_sum(s2); if (c.lane < 16) ssp[(size_t)m * 16 + c.lane] = (c.lane == 0) ? s2 : 0.f; } } } }
}

#undef a
__device__ __forceinline__ void prologue2(const Ctx& c0, unsigned char* ws) {
    const Ctx c = launder(c0);
    for (int w = blockIdx.x; w < 192; w += c.G) {
        pg8::Gemm g; pg8::OneUnit S; EpiPlain E; S.have = true; E.O2 = nullptr; E.split = 1 << 30;
        if (w < 128) {
            const int j = w >> 6, r = w & 63; unsigned char* tmp = ws + WS_TMP + (size_t)j * TMP_STRIDE; unsigned char* wl = ws + WS_WT + (size_t)(3 * j) * WT_LAYER;
            if (r < 32) { const int h = r >> 2, pn = r & 3;
                g.A = (const bf16_t*)(tmp + TMP_WUKT) + (size_t)h * 256 * 128; g.lda = 128; g.Bt = (const bf16_t*)(tmp + TMP_WNAT) + h * 128 + 32; g.ldb = 2672; g.K = 128;
                S.pm = 0; S.pn = pn; E.O = (bf16_t*)(wl + WT_IN) + (size_t)h * 256 * DM; E.ldc = DM;
            } else { const int h = (r - 32) >> 2, pm = (r - 32) & 3;
                g.A = (const bf16_t*)(tmp + TMP_WOT) + h * 128; g.lda = 1280; g.Bt = (const bf16_t*)(tmp + TMP_WUVN) + h * 128; g.ldb = 1024; g.K = 128;
                S.pm = pm; S.pn = 0; E.O = (bf16_t*)(wl + WT_OUT) + h * 256; E.ldc = LDOA;
            }
        } else {
            const int l = (w - 128) >> 4, r = (w - 128) & 15;
            g.A = (const bf16_t*)(ws + WS_MEMN); g.lda = DM; g.Bt = (const bf16_t*)(ws + WS_WT + (size_t)l * WT_LAYER + WT_MKV); g.ldb = DM; g.K = DM;
            S.pm = r >> 1; S.pn = r & 1; E.O = (bf16_t*)(ws + WS_KVM + (size_t)l * 2 * MiB); E.ldc = 512;
        }
        pg8::gemm_phase<EpiPlain, pg8::OneUnit>(c.lds, g, S, E, c.wave);
    }
}

template <int D>
__device__ __forceinline__ void wave_attn(const bf16_t* q, long qs, const bf16_t* k, const bf16_t* v, long ks, int t0, int t1, int tq, int W, float sc_l2,
                                          float& m, float& l, f32x16 (&O)[D / 32], LAS unsigned char* vbuf, int lane) {
    constexpr int NS = D / 16, ND = D / 32, VP = D * 2 + 16;
    const int r32 = lane & 31, hi = lane >> 5;
    bf16x8 qf[NS];
#pragma unroll
    for (int s = 0; s < NS; ++s) qf[s] = *(const GAS bf16x8*)(q + (long)r32 * qs + 16 * s + 8 * hi);
    constexpr int LPR = D / 8;
    constexpr int RPI = 64 / LPR;
    bf16x8 kf[NS]; u32x4 tmp[32 / RPI];
#define WA_LOAD(tt_) do { const bf16_t* kt = k + (long)(32 * (tt_) + r32) * ks + 8 * hi; \
        _Pragma("unroll") for (int s = 0; s < NS; ++s) kf[s] = *(const GAS bf16x8*)(kt + 16 * s); \
        const bf16_t* vt = v + (long)(32 * (tt_)) * ks; \
        _Pragma("unroll") for (int i = 0; i < 32 / RPI; ++i) { const int row = i * RPI + lane / LPR; tmp[i] = *(const GAS u32x4*)(vt + (long)row * ks + (lane % LPR) * 8); } } while (0)
    WA_LOAD(t0);
    for (int t = t0; t <= t1; ++t) {
        f32x16 S = {};
        __builtin_amdgcn_s_setprio(1);
#pragma unroll
        for (int s = 0; s < NS; ++s) S = __builtin_amdgcn_mfma_f32_32x32x16_bf16(kf[s], qf[s], S, 0, 0, 0);
        __builtin_amdgcn_s_setprio(0);
        asm volatile("" ::: "memory");
#pragma unroll
        for (int i = 0; i < 32 / RPI; ++i) { const int row = i * RPI + lane / LPR; *(LAS u32x4*)(vbuf + row * VP + (lane % LPR) * 16) = tmp[i]; }
        asm volatile("" ::: "memory");
        if (t < t1) { WA_LOAD(t + 1); }
        float mt = NEGBIG;
        if (W >= 0 && (t == t1 || 32 * (t - tq) - 31 < -W)) {
            const int db = 32 * (t - tq) - r32 + 4 * hi;
#pragma unroll
            for (int r = 0; r < 16; ++r) { const int dl = db + (r & 3) + 8 * (r >> 2); const bool ok = (dl <= 0) && (dl >= -W); S[r] = ok ? S[r] : NEGBIG; mt = fmaxf(mt, S[r]); }
        } else {
#pragma unroll
            for (int r = 0; r < 16; ++r) mt = fmaxf(mt, S[r]);
        }
        mt = xmax32(mt) * sc_l2;
        const float mn = fmaxf(m, mt);
        if (__any(mn > m + 8.0f)) {
            const float al = fexp2(m - mn); l *= al;
#pragma unroll
            for (int d = 0; d < ND; ++d)
#pragma unroll
                for (int r = 0; r < 16; ++r) O[d][r] *= al;
            m = mn;
        }
        float ps = 0.f;
#pragma unroll
        for (int r = 0; r < 16; ++r) { S[r] = fexp2(__builtin_fmaf(S[r], sc_l2, -m)); ps += S[r]; }
        l += ps;
        bf16x8 pf[2];
#pragma unroll
        for (int s2 = 0; s2 < 2; ++s2) { u32x4 w; w.x = cvt_pk_bf16(S[8 * s2 + 0], S[8 * s2 + 1]); w.y = cvt_pk_bf16(S[8 * s2 + 2], S[8 * s2 + 3]); w.z = cvt_pk_bf16(S[8 * s2 + 4], S[8 * s2 + 5]); w.w = cvt_pk_bf16(S[8 * s2 + 6], S[8 * s2 + 7]);
            pf[s2] = __builtin_bit_cast(bf16x8, w); }
        {
            const int blk = (lane >> 4) & 1, qq = (lane & 15) >> 2, pp = lane & 3;
            const LAS unsigned char* vb = vbuf + (4 * hi + qq) * VP + (16 * blk + 4 * pp) * 2;
            __builtin_amdgcn_s_setprio(1);
#pragma unroll
            for (int d = 0; d < ND; ++d)
#pragma unroll
                for (int s2 = 0; s2 < 2; ++s2) {
                    const s16x4 lo = __builtin_amdgcn_ds_read_tr16_b64_v4i16((LAS s16x4*)(vb + (16 * s2) * VP + d * 64));
                    const s16x4 hi4 = __builtin_amdgcn_ds_read_tr16_b64_v4i16((LAS s16x4*)(vb + (16 * s2 + 8) * VP + d * 64));
                    const bf16x8 vf = (bf16x8){lo[0], lo[1], lo[2], lo[3], hi4[0], hi4[1], hi4[2], hi4[3]};
                    O[d] = __builtin_amdgcn_mfma_f32_32x32x16_bf16(vf, pf[s2], O[d], 0, 0, 0);
                }
            __builtin_amdgcn_s_setprio(0);
        }
    }
}
#undef WA_LOAD
template <int D>
__device__ __forceinline__ void wave_attn2(const bf16_t* q, long qs, const bf16_t* k, const bf16_t* v, long ks, int t0, int t1, int tq, int W, float sc_l2,
                                           float (&m)[2], float (&l)[2], f32x16 (&O)[2][D / 32], LAS unsigned char* vbuf, int lane) {
    constexpr int NS = D / 16, ND = D / 32, VP = D * 2 + 16;
    const int r32 = lane & 31, hi = lane >> 5;
    bf16x8 qf[2][NS];
#pragma unroll
    for (int u = 0; u < 2; ++u)
#pragma unroll
        for (int s = 0; s < NS; ++s) qf[u][s] = *(const GAS bf16x8*)(q + (long)(32 * u + r32) * qs + 16 * s + 8 * hi);
    constexpr int LPR = D / 8, RPI = 64 / LPR;
    bf16x8 kf[NS]; u32x4 tmp[32 / RPI];
#define WA_LOAD(tt_) do { const bf16_t* kt = k + (long)(32 * (tt_) + r32) * ks + 8 * hi; \
        _Pragma("unroll") for (int s = 0; s < NS; ++s) kf[s] = *(const GAS bf16x8*)(kt + 16 * s); \
        const bf16_t* vt = v + (long)(32 * (tt_)) * ks; \
        _Pragma("unroll") for (int i = 0; i < 32 / RPI; ++i) { const int row = i * RPI + lane / LPR; tmp[i] = *(const GAS u32x4*)(vt + (long)row * ks + (lane % LPR) * 8); } } while (0)
    WA_LOAD(t0);
    for (int t = t0; t <= t1; ++t) {
        f32x16 S[2];
        bool act[2];
#pragma unroll
        for (int u = 0; u < 2; ++u) { act[u] = (W < 0) || (t <= tq + u && t >= tq + u - 4);
            S[u] = (f32x16){};
            if (act[u]) {
#pragma unroll
                for (int s = 0; s < NS; ++s) S[u] = __builtin_amdgcn_mfma_f32_32x32x16_bf16(kf[s], qf[u][s], S[u], 0, 0, 0); } }
        asm volatile("" ::: "memory");
#pragma unroll
        for (int i = 0; i < 32 / RPI; ++i) { const int row = i * RPI + lane / LPR; *(LAS u32x4*)(vbuf + row * VP + (lane % LPR) * 16) = tmp[i]; }
        asm volatile("" ::: "memory");
        if (t < t1) { WA_LOAD(t + 1); }
        bf16x8 pf[2][2];
#pragma unroll
        for (int u = 0; u < 2; ++u) {
            if (act[u]) {
                float mt = NEGBIG; const int tqu = tq + u;
                if (W >= 0 && (t == tqu || 32 * (t - tqu) - 31 < -W)) {
                    const int db = 32 * (t - tqu) - r32 + 4 * hi;
#pragma unroll
                    for (int r = 0; r < 16; ++r) { const int dl = db + (r & 3) + 8 * (r >> 2); const bool ok = (dl <= 0) && (dl >= -W); S[u][r] = ok ? S[u][r] : NEGBIG; mt = fmaxf(mt, S[u][r]); }
                } else {
#pragma unroll
                    for (int r = 0; r < 16; ++r) mt = fmaxf(mt, S[u][r]);
                }
                mt = xmax32(mt) * sc_l2;
                const float mn = fmaxf(m[u], mt);
                if (__any(mn > m[u] + 8.0f)) {
                    const float al = fexp2(m[u] - mn); l[u] *= al;
#pragma unroll
                    for (int d = 0; d < ND; ++d)
#pragma unroll
                        for (int r = 0; r < 16; ++r) O[u][d][r] *= al;
                    m[u] = mn;
                }
                float ps = 0.f;
#pragma unroll
                for (int r = 0; r < 16; ++r) { S[u][r] = fexp2(__builtin_fmaf(S[u][r], sc_l2, -m[u])); ps += S[u][r]; }
                l[u] += ps;
#pragma unroll
                for (int s2 = 0; s2 < 2; ++s2) { u32x4 w; w.x = cvt_pk_bf16(S[u][8 * s2 + 0], S[u][8 * s2 + 1]); w.y = cvt_pk_bf16(S[u][8 * s2 + 2], S[u][8 * s2 + 3]); w.z = cvt_pk_bf16(S[u][8 * s2 + 4], S[u][8 * s2 + 5]); w.w = cvt_pk_bf16(S[u][8 * s2 + 6], S[u][8 * s2 + 7]);
                    pf[u][s2] = __builtin_bit_cast(bf16x8, w); }
            } else { pf[u][0] = (bf16x8){0, 0, 0, 0, 0, 0, 0, 0}; pf[u][1] = (bf16x8){0, 0, 0, 0, 0, 0, 0, 0}; }
        }
        {
            const int blk = (lane >> 4) & 1, qq = (lane & 15) >> 2, pp = lane & 3;
            const LAS unsigned char* vb = vbuf + (4 * hi + qq) * VP + (16 * blk + 4 * pp) * 2;
            __builtin_amdgcn_s_setprio(1);
#pragma unroll
            for (int d = 0; d < ND; ++d)
#pragma unroll
                for (int s2 = 0; s2 < 2; ++s2) {
                    const s16x4 lo = __builtin_amdgcn_ds_read_tr16_b64_v4i16((LAS s16x4*)(vb + (16 * s2) * VP + d * 64));
                    const s16x4 hi4 = __builtin_amdgcn_ds_read_tr16_b64_v4i16((LAS s16x4*)(vb + (16 * s2 + 8) * VP + d * 64));
                    const bf16x8 vf = (bf16x8){lo[0], lo[1], lo[2], lo[3], hi4[0], hi4[1], hi4[2], hi4[3]};
                    O[0][d] = __builtin_amdgcn_mfma_f32_32x32x16_bf16(vf, pf[0][s2], O[0][d], 0, 0, 0);
                    O[1][d] = __builtin_amdgcn_mfma_f32_32x32x16_bf16(vf, pf[1][s2], O[1][d], 0, 0, 0);
                }
            __builtin_amdgcn_s_setprio(0);
        }
    }
#undef WA_LOAD
}
template <int D>
__device__ __forceinline__ void store_ot(const f32x16 (&O)[D / 32], float inv_l, bf16_t* out, long os, int lane) {
    const int r32 = lane & 31, hi = lane >> 5;
#pragma unroll
    for (int d = 0; d < D / 32; ++d)
#pragma unroll
        for (int g = 0; g < 4; ++g) { u32x2 w; w.x = cvt_pk_bf16(O[d][4 * g] * inv_l, O[d][4 * g + 1] * inv_l); w.y = cvt_pk_bf16(O[d][4 * g + 2] * inv_l, O[d][4 * g + 3] * inv_l);
            *(GAS u32x2*)(out + (long)r32 * os + 32 * d + 8 * g + 4 * hi) = w; }
}

template <int D>
__device__ __forceinline__ void stage_ot(const f32x16 (&O)[D / 32], float sc, LAS unsigned char* stg, int lane) {
    constexpr int VP = D * 2 + 16; const int r32 = lane & 31, hi = lane >> 5;
    asm volatile("" ::: "memory");
#pragma unroll
    for (int d = 0; d < D / 32; ++d)
#pragma unroll
        for (int g = 0; g < 4; ++g) { u32x2 w; w.x = cvt_pk_bf16(O[d][4 * g] * sc, O[d][4 * g + 1] * sc); w.y = cvt_pk_bf16(O[d][4 * g + 2] * sc, O[d][4 * g + 3] * sc);
            *(LAS u32x2*)(stg + r32 * VP + (32 * d + 8 * g + 4 * hi) * 2) = w; }
    asm volatile("" ::: "memory");
}
template <int D>
__device__ __forceinline__ void store_staged(const LAS unsigned char* stg, bf16_t* out, long os, int lane) {
    constexpr int VP = D * 2 + 16, LPR = D / 8, RPI = 64 / LPR;
#pragma unroll
    for (int i = 0; i < 32 / RPI; ++i) { const int row = i * RPI + lane / LPR; const u32x4 v = *(const LAS u32x4*)(stg + row * VP + (lane % LPR) * 16); *(GAS u32x4*)(out + (long)row * os + (lane % LPR) * 8) = v; }
    asm volatile("" ::: "memory");
}

__device__ __forceinline__ void mem_attn_units(const Ctx& c0, bf16_t* Obase, int ldo, int coloff, const bf16_t* kvm) {
    const Ctx c = launder(c0);
    LAS unsigned char* vbuf = c.lds + c.wave * 8704;
    for (int u = c.gw; u < 2048; u += c.NGW) {
        const int qt = u & 63, h = (u >> 6) & 3, b = u >> 8;
        bf16_t* q = Obase + (size_t)(b * SEQ + 64 * qt) * ldo + coloff + h * 64;
        const bf16_t* k = kvm + (size_t)(b * MEMLEN) * 512 + h * 64;
        float m[2] = {NEGBIG, NEGBIG}, l[2] = {0.f, 0.f}; f32x16 O[2][2] = {};
        wave_attn2<64>(q, ldo, k, k + 256, 512, 0, 7, 0, -1, 0.125f * LOG2E, m, l, O, vbuf, c.lane);
#pragma unroll
        for (int s = 0; s < 2; ++s) { const float ls = xsum32(l[s]);
            stage_ot<64>(O[s], 1.0f / ls, vbuf, c.lane); store_staged<64>(vbuf, q + (size_t)(32 * s) * ldo, ldo, c.lane); }
    }
}

__device__ __forceinline__ void swa_units(const Ctx& c0, unsigned char* ws, const float* sinks) {
    const Ctx c = launder(c0);
    LAS unsigned char* vbuf = c.lds + c.wave * 8704;
    bf16_t* OB = (bf16_t*)(ws + WS_OB); const bf16_t* KB = (const bf16_t*)(ws + WS_KB); const bf16_t* VB = (const bf16_t*)(ws + WS_VB);
    for (int u = c.gw; u < 8192; u += c.NGW) {
        const int qt2 = u & 63, h = (u >> 6) & 15, b = u >> 10, kvh = h >> 2, qt = 2 * qt2;
        bf16_t* q = OB + (size_t)(b * SEQ + 32 * qt) * LDOB + h * 64;
        const bf16_t* k = KB + (size_t)(b * SEQ) * 256 + kvh * 64; const bf16_t* v = VB + (size_t)(b * SEQ) * 256 + kvh * 64;
        const float sk = ((const GAS float*)sinks)[h] * LOG2E, l0 = (c.lane < 32) ? 1.f : 0.f;
        float m[2] = {sk, sk}, l[2] = {l0, l0}; f32x16 O[2][2] = {};
        const int t0 = qt - 4 < 0 ? 0 : qt - 4;
        wave_attn2<64>(q, LDOB, k, v, 256, t0, qt + 1, qt, 127, 0.125f * LOG2E, m, l, O, vbuf, c.lane);
#pragma unroll
        for (int s = 0; s < 2; ++s) { const float ls = xsum32(l[s]);
            stage_ot<64>(O[s], 1.0f / ls, vbuf, c.lane); store_staged<64>(vbuf, q + (size_t)(32 * s) * LDOB, LDOB, c.lane); }
    }
}

__device__ __forceinline__ void dil_units(const Ctx& c0, unsigned char* ws, bf16_t* p1buf, int br_lo, int br_hi) {
    const Ctx c = launder(c0);
    LAS unsigned char* vbuf = c.lds + c.wave * 8704;
    bf16_t* OC = (bf16_t*)(ws + WS_OC); const bf16_t* KC = (const bf16_t*)(ws + WS_KC); const bf16_t* VC = (const bf16_t*)(ws + WS_VC);
    GAS float* LSE = (GAS float*)(ws + WS_LSE);
    const int nun = (br_hi - br_lo) * 8192;
    const float sc = 0.08838834764831845f * LOG2E;
    for (int uu = c.gw; uu < nun; uu += c.NGW) {
        const int br = br_lo + (uu >> 13), u = uu & 8191;
        const int dsh = 2 * br, d = 1 << dsh, tps = 128 >> dsh;
        const int bh = u >> 7, b = bh >> 3, h = bh & 7, rho = (u & 127) / tps, tq = (u & 127) % tps;
        const size_t tok0 = (size_t)b * SEQ + rho;
        bf16_t* q = OC + (tok0 + (size_t)d * 32 * tq) * LDOB + h * 128;
        const bf16_t* k = KC + tok0 * 1024 + h * 128; const bf16_t* v = VC + tok0 * 1024 + h * 128;
        float m = NEGBIG, l = 0.f; f32x16 O[4] = {};
        const int t0 = tq - 4 < 0 ? 0 : tq - 4;
        float l0 = 0.f, l1 = 0.f;
        if (br == 2) { const size_t tk = tok0 + (size_t)d * (32 * tq + (c.lane & 31)); l0 = LSE[tk * 8 + h]; l1 = LSE[(size_t)MTOK * 8 + tk * 8 + h]; }
        wave_attn<128>(q, (long)d * LDOB, k, v, (long)d * 1024, t0, tq, tq, 128, sc, m, l, O, vbuf, c.lane);
        l = xsum32(l);
        const float inv_l = 1.0f / l, lse = m + __log2f(l);
        int tq_ = tq, rho_ = rho; asm volatile("" : "+s"(tq_), "+s"(rho_));
        const int ln = lane_id(), r32 = ln & 31, hi = ln >> 5;
        const size_t tok0b = (size_t)b * SEQ + rho_;
        const size_t tok = tok0b + (size_t)d * (32 * tq_ + r32);
        if (br < 2) {
            bf16_t* P = (br == 0) ? p1buf : (bf16_t*)(ws + WS_P2);
            stage_ot<128>(O, inv_l, vbuf, ln); store_staged<128>(vbuf, P + (tok0b + (size_t)d * 32 * tq_) * 1024 + h * 128, (long)d * 1024, ln);
            if (hi == 0) LSE[(size_t)br * MTOK * 8 + tok * 8 + h] = lse;
        } else {
            const float mx = fmaxf(fmaxf(l0, l1), lse);
            float w0 = fexp2(l0 - mx), w1 = fexp2(l1 - mx), w2 = fexp2(lse - mx); const float ws_ = 1.0f / (w0 + w1 + w2); w0 *= ws_; w1 *= ws_; w2 *= ws_ * inv_l;
            stage_ot<128>(O, w2, vbuf, ln);
            if (hi == 0) *(LAS f32x2*)(vbuf + r32 * 272 + 256) = (f32x2){w0, w1};
            asm volatile("" ::: "memory");
            const size_t tokq0 = tok0b + (size_t)d * 32 * tq_;
            u32x4 a1[8], a2[8];
#pragma unroll
            for (int i = 0; i < 8; ++i) { const int row = i * 4 + (ln >> 4), chv = ln & 15; const size_t tr = tokq0 + (size_t)d * row;
                a1[i] = *(const GAS u32x4*)((const bf16_t*)p1buf + tr * 1024 + h * 128 + chv * 8); a2[i] = *(const GAS u32x4*)((const bf16_t*)(ws + WS_P2) + tr * 1024 + h * 128 + chv * 8); }
            __builtin_amdgcn_sched_barrier(0);
#pragma unroll
            for (int i = 0; i < 8; ++i) { const int row = i * 4 + (ln >> 4), chv = ln & 15; const size_t tr = tokq0 + (size_t)d * row;
                const u32x4 a3 = *(const LAS u32x4*)(vbuf + row * 272 + chv * 16); const f32x2 ww = *(const LAS f32x2*)(vbuf + row * 272 + 256);
                u32x4 w;
#pragma unroll
                for (int e = 0; e < 4; ++e) w[e] = cvt_pk_bf16(ww.x * bflo(a1[i][e]) + ww.y * bflo(a2[i][e]) + bflo(a3[e]), ww.x * bfhi(a1[i][e]) + ww.y * bfhi(a2[i][e]) + bfhi(a3[e]));
                *(GAS u32x4*)(OC + tr * LDOB + h * 128 + chv * 8) = w; }
            asm volatile("" ::: "memory");
        }
    }
}

__device__ __forceinline__ void ckv_norm_rows(const Ctx& c0, unsigned char* ws, const float* gain) {
    const Ctx c = launder(c0);
    bf16_t* CKV = (bf16_t*)(ws + WS_CKV);
    const f32x4 g = *((const f32x4*)gain + c.lane);
    for (int m0 = c.gw; m0 < MTOK; m0 += 4 * c.NGW) {
        u32x2 w[4];
#pragma unroll
        for (int j = 0; j < 4; ++j) { const int m = m0 + j * c.NGW; w[j] = *((const GAS u32x2*)(CKV + (size_t)(m < MTOK ? m : MTOK - 1) * CKVP) + c.lane); }
#pragma unroll
        for (int j = 0; j < 4; ++j) { const int m = m0 + j * c.NGW;
            const float v0 = bflo(w[j].x), v1 = bfhi(w[j].x), v2 = bflo(w[j].y), v3 = bfhi(w[j].y);
            const float rstd = __builtin_amdgcn_rsqf(wave_sum(v0 * v0 + v1 * v1 + v2 * v2 + v3 * v3) * (1.f / 256.f) + EPS);
            u32x2 o; o.x = cvt_pk_bf16(v0 * rstd * g.x, v1 * rstd * g.y); o.y = cvt_pk_bf16(v2 * rstd * g.z, v3 * rstd * g.w);
            if (m < MTOK) *((GAS u32x2*)(CKV + (size_t)m * CKVP) + c.lane) = o; }
    }
}
__device__ __forceinline__ void hist_select(const LAS unsigned* hist, int K, int lane, int& bin, int& above, int& inbin) {
    const u32x4 hc = *(const LAS u32x4*)(hist + 4 * lane);
    const int tot = (int)(hc.x + hc.y + hc.z + hc.w);
    int pre = tot;
#define HS_DPP(v_, ctl_, rm_) __builtin_amdgcn_update_dpp(0, (v_), (ctl_), (rm_), 0xf, true)
    pre += HS_DPP(pre, 0x111, 0xf); pre += HS_DPP(pre, 0x112, 0xf); pre += HS_DPP(pre, 0x114, 0xf); pre += HS_DPP(pre, 0x118, 0xf);
    pre += HS_DPP(pre, 0x142, 0xa);
    pre += HS_DPP(pre, 0x143, 0xc);
#undef HS_DPP
    const int all = __builtin_amdgcn_readlane(pre, 63);
    const int suf = all - pre + tot;
    const unsigned long long bal = __ballot(suf >= K);
    const int L = __builtin_amdgcn_readfirstlane(63 - __builtin_clzll(bal | 1ull));
    const int sufL = __builtin_amdgcn_readlane(suf, L), totL = __builtin_amdgcn_readlane(tot, L);
    const int c3 = __builtin_amdgcn_readlane((int)hc.w, L), c2 = __builtin_amdgcn_readlane((int)hc.z, L), c1 = __builtin_amdgcn_readlane((int)hc.y, L), c0 = __builtin_amdgcn_readlane((int)hc.x, L);
    int ab = sufL - totL;
    if (ab + c3 >= K) { bin = 4 * L + 3; above = ab; inbin = c3; return; } ab += c3;
    if (ab + c2 >= K) { bin = 4 * L + 2; above = ab; inbin = c2; return; } ab += c2;
    if (ab + c1 >= K) { bin = 4 * L + 1; above = ab; inbin = c1; return; } ab += c1;
    bin = 4 * L; above = ab; inbin = c0;
}
__device__ __forceinline__ int f2ord(float f) { const int b = __builtin_bit_cast(int, f); return b >= 0 ? b : (b ^ 0x7fffffff); }
__device__ __forceinline__ float ord2f(int o) { return __builtin_bit_cast(float, o >= 0 ? o : (o ^ 0x7fffffff)); }
constexpr int IX_CMAX = 128;
#define IX_KEY(v_) ({ int k_ = (int)(((v_) - mn) * scale); k_ > 65535 ? 65535 : (k_ < 0 ? 0 : k_); })
__device__ __forceinline__ void select_token(const LAS float* row, LAS unsigned* hist, LAS unsigned* cand, int n, float mn, float mx, unsigned short* out_, int lane) {
    GAS unsigned short* out = (GAS unsigned short*)out_;
    if (n <= 256) {
#pragma unroll
        for (int i = 0; i < 4; ++i) { const int j = lane + 64 * i; out[j] = (unsigned short)(j < n ? j : 0); }
        return;
    }
    const float scale = (mx > mn) ? 65535.0f / (mx - mn) : 0.f;
    LAS unsigned short* stg = (LAS unsigned short*)hist;
#define IX_FLUSH() do { asm volatile("" ::: "memory"); const u32x2 fv_ = *(const LAS u32x2*)(hist + 2 * lane); *(GAS u32x2*)(out + 4 * lane) = fv_; asm volatile("" ::: "memory"); } while (0)
    { unsigned z = 0u; asm volatile("" : "+v"(z)); *(LAS u32x4*)(hist + 4 * lane) = (u32x4){z, z, z, z}; }
    for (int j0 = lane; j0 < n; j0 += 512) {
        float v[8];
#pragma unroll
        for (int k = 0; k < 8; ++k) { const int j = j0 + 64 * k; v[k] = (j < n) ? row[j] : mn; }
#pragma unroll
        for (int k = 0; k < 8; ++k) { const int j = j0 + 64 * k; const int key = IX_KEY(v[k]);
            if (j < n) __hip_atomic_fetch_add(hist + (key >> 8), 1u, __ATOMIC_RELAXED, __HIP_MEMORY_SCOPE_WORKGROUP); }
    }
    int b1, ab1, in1; hist_select(hist, 256, lane, b1, ab1, in1);
    const int K2 = 256 - ab1;
    if (in1 <= IX_CMAX) {
        { unsigned z = 0u; asm volatile("" : "+v"(z)); if (lane < IX_CMAX / 4) *(LAS u32x4*)(cand + 4 * lane) = (u32x4){z, z, z, z}; }
        int base = 0, cb = 0;
        for (int j0 = lane; j0 < n; j0 += 512) {
            float v[8];
#pragma unroll
            for (int k = 0; k < 8; ++k) { const int j = j0 + 64 * k; v[k] = (j < n) ? row[j] : mn; }
#pragma unroll
            for (int k = 0; k < 8; ++k) {
                const int j = j0 + 64 * k; const int key = IX_KEY(v[k]); const int bin = (j < n) ? (key >> 8) : -1;
                const bool gt = bin > b1, eq = bin == b1;
                const unsigned long long bg = __ballot(gt), be = __ballot(eq);
                const int pg = base + (int)__builtin_amdgcn_mbcnt_hi((unsigned)(bg >> 32), __builtin_amdgcn_mbcnt_lo((unsigned)bg, 0u));
                const int pe = cb + (int)__builtin_amdgcn_mbcnt_hi((unsigned)(be >> 32), __builtin_amdgcn_mbcnt_lo((unsigned)be, 0u));
                if (gt && pg < 256) stg[pg] = (unsigned short)j;
                if (eq && pe < IX_CMAX) cand[pe] = ((unsigned)(key & 255) << 16) | (unsigned)(0xFFFF - j);
                base += __builtin_popcountll(bg); cb += __builtin_popcountll(be);
            }
        }
#pragma unroll
        for (int h = 0; h < IX_CMAX / 64; ++h) { const int i = lane + 64 * h;
            if (i < in1) { const unsigned me = cand[i]; int rank = 0; for (int c2 = 0; c2 < in1; c2 += 4) { const u32x4 q4 = *(const LAS u32x4*)(cand + c2); rank += (q4.x > me ? 1 : 0) + (q4.y > me ? 1 : 0) + (q4.z > me ? 1 : 0) + (q4.w > me ? 1 : 0); }
                if (rank < K2) stg[ab1 + rank] = (unsigned short)(0xFFFF - (me & 0xFFFFu)); } }
        IX_FLUSH();
        return;
    }
    { unsigned z = 0u; asm volatile("" : "+v"(z)); *(LAS u32x4*)(hist + 4 * lane) = (u32x4){z, z, z, z}; }
    for (int j0 = lane; j0 < n; j0 += 64) { const int key = IX_KEY(row[j0]); if ((key >> 8) == b1) __hip_atomic_fetch_add(hist + (key & 255), 1u, __ATOMIC_RELAXED, __HIP_MEMORY_SCOPE_WORKGROUP); }
    int b2, ab2, in2; hist_select(hist, K2, lane, b2, ab2, in2);
    const int T = (b1 << 8) | b2, krem = K2 - ab2;
    int base = 0, eqb = 0;
    for (int j0 = 0; j0 < n; j0 += 64) {
        const int j = j0 + lane; const int key = (j < n) ? IX_KEY(row[j]) : -1;
        const bool gt = key > T, eq = key == T;
        const unsigned long long beq = __ballot(eq);
        const int rk = eqb + (int)__builtin_amdgcn_mbcnt_hi((unsigned)(beq >> 32), __builtin_amdgcn_mbcnt_lo((unsigned)beq, 0u));
        const bool sel = gt || (eq && rk < krem);
        const unsigned long long bs = __ballot(sel);
        const int pos = base + (int)__builtin_amdgcn_mbcnt_hi((unsigned)(bs >> 32), __builtin_amdgcn_mbcnt_lo((unsigned)bs, 0u));
        if (sel && pos < 256) stg[pos] = (unsigned short)j;
        base += __builtin_popcountll(bs); eqb += __builtin_popcountll(beq);
    }
    IX_FLUSH();
}
#undef IX_FLUSH
#undef IX_KEY
constexpr int IDX_ROWW = 4224;
__device__ __forceinline__ void indexer_load_q(bf16x8 (&af)[4][4], const bf16_t* QI, size_t tokb, int t0) {
    const int lane = lane_id(), r32 = lane & 31, hi = lane >> 5, tk = (r32 >> 2) & 1, hd = (r32 & 3) + 4 * (r32 >> 3);
#pragma unroll
    for (int p = 0; p < 4; ++p) { const bf16_t* qrow = QI + (tokb + t0 + 2 * p + tk) * 1024 + hd * 64 + 8 * hi;
#pragma unroll
        for (int s = 0; s < 4; ++s) af[p][s] = *(const GAS bf16x8*)(qrow + 16 * s); }
}
__device__ __forceinline__ void indexer_scores(const bf16x8 (&af)[4][4], const bf16_t* KI, const float* WI, size_t tokb, int t0, int ntile, int rot, LAS float* sc, int coff, float (&lo_out)[4], float (&hi_out)[4], LAS f32x4* WVL, int w) {
    const int lane = lane_id();
    const int r32 = lane & 31, hi = lane >> 5;
    float lo4[4], hi4[4];
#pragma unroll
    for (int p = 0; p < 4; ++p) { lo4[p] = 3.0e38f; hi4[p] = -3.0e38f; }
    const f32x4 wv_ = *((const GAS f32x4*)(WI + (tokb + t0 + ((lane & 31) >> 2)) * 16) + (lane & 3));
    bf16x8 k0[4], k1[4], k2[4];
#define IXS_LOAD(dst_, tile_) do { const bf16_t* krow = KI + (tokb + 32 * (tile_) + r32) * 64 + 8 * hi; _Pragma("unroll") for (int s = 0; s < 4; ++s) dst_[s] = *(const GAS bf16x8*)(krow + 16 * s); } while (0)
#define IXS_COMP(kf_, tile_) do { f32x16 acc0 = {}, acc1 = {}, acc2 = {}, acc3 = {};                    \
        _Pragma("unroll") for (int s = 0; s < 4; ++s) { acc0 = __builtin_amdgcn_mfma_f32_32x32x16_bf16(af[0][s], kf_[s], acc0, 0, 0, 0); acc1 = __builtin_amdgcn_mfma_f32_32x32x16_bf16(af[1][s], kf_[s], acc1, 0, 0, 0); \
            acc2 = __builtin_amdgcn_mfma_f32_32x32x16_bf16(af[2][s], kf_[s], acc2, 0, 0, 0); acc3 = __builtin_amdgcn_mfma_f32_32x32x16_bf16(af[3][s], kf_[s], acc3, 0, 0, 0); } \
        IXS_RED(0, acc0, tile_); IXS_RED(1, acc1, tile_); IXS_RED(2, acc2, tile_); IXS_RED(3, acc3, tile_); } while (0)
#define IXS_RED(p, acc, tile_) do { float s0 = 0.f, s1 = 0.f; \
            _Pragma("unroll") for (int r4 = 0; r4 < 4; ++r4) { const f32x4 wq = WVL[(2 * (p) + hi) * 4 + r4]; \
                s0 += wq[0] * __builtin_amdgcn_fmed3f(acc[4 * r4], 0.f, 3.0e38f); s1 += wq[1] * __builtin_amdgcn_fmed3f(acc[4 * r4 + 1], 0.f, 3.0e38f); s0 += wq[2] * __builtin_amdgcn_fmed3f(acc[4 * r4 + 2], 0.f, 3.0e38f); s1 += wq[3] * __builtin_amdgcn_fmed3f(acc[4 * r4 + 3], 0.f, 3.0e38f); } \
            const float sv = s0 + s1; sc[(2 * (p) + hi) * IDX_ROWW + coff + 32 * (tile_) + r32] = sv; lo4[p] = fminf(lo4[p], sv); hi4[p] = fmaxf(hi4[p], sv); } while (0)
    int tile = (w - rot) & 7;
    const int tlast = ntile - 1;
#define IXS_CL(t_) ((t_) < tlast ? (t_) : tlast)
    IXS_LOAD(k0, IXS_CL(tile)); IXS_LOAD(k1, IXS_CL(tile + 8)); IXS_LOAD(k2, IXS_CL(tile + 16));
    if (lane < 32) WVL[lane] = wv_;
    for (; tile < ntile; tile += 24) {
        IXS_COMP(k0, tile); IXS_LOAD(k0, IXS_CL(tile + 24));
        if (tile + 8 < ntile) IXS_COMP(k1, tile + 8);
        IXS_LOAD(k1, IXS_CL(tile + 32));
        if (tile + 16 < ntile) IXS_COMP(k2, tile + 16);
        IXS_LOAD(k2, IXS_CL(tile + 40));
    }
#undef IXS_CL
#undef IXS_LOAD
#undef IXS_COMP
#undef IXS_RED
#pragma unroll
    for (int p = 0; p < 4; ++p) { lo_out[p] = lo4[p]; hi_out[p] = hi4[p]; }
}
__device__ __forceinline__ void indexer_minmax(const float (&lo4)[4], const float (&hi4)[4], LAS int* mm) {
    const int lane = lane_id(), r32 = lane & 31, hi = lane >> 5;
#pragma unroll
    for (int p = 0; p < 4; ++p) { const float lo = half_min(lo4[p]), hx = half_max(hi4[p]);
        if (r32 == 0) { __hip_atomic_fetch_min(mm + 2 * (2 * p + hi), f2ord(lo), __ATOMIC_RELAXED, __HIP_MEMORY_SCOPE_WORKGROUP);
                        __hip_atomic_fetch_max(mm + 2 * (2 * p + hi) + 1, f2ord(hx), __ATOMIC_RELAXED, __HIP_MEMORY_SCOPE_WORKGROUP); } }
}
__device__ __forceinline__ void indexer_phase(const Ctx& c0, unsigned char* ws) {
    const Ctx c = launder(c0);
    const bf16_t* QI = (const bf16_t*)(ws + WS_QI); const bf16_t* KI = (const bf16_t*)(ws + WS_KI); const float* WI = (const float*)(ws + WS_WI);
    unsigned short* IDX = (unsigned short*)(ws + WS_IDX);
    LAS float* sc = (LAS float*)c.lds;
    LAS unsigned* hist = (LAS unsigned*)(c.lds + 8 * IDX_ROWW * 4) + c.wave * 256;
    LAS int* mm = (LAS int*)(c.lds + 8 * IDX_ROWW * 4 + 8 * 1024);
    LAS f32x4* WVL = (LAS f32x4*)(c.lds + 8 * IDX_ROWW * 4 + 8 * 1024 + 256 + c.wave * 512);
    LAS unsigned* cand = (LAS unsigned*)(c.lds + 8 * IDX_ROWW * 4 + 8 * 1024 + 256 + 4096 + c.wave * (IX_CMAX * 4));
    const int lane = c.lane, w = c.wave;
    if (c.tid < 32) mm[c.tid] = (c.tid & 1) ? (int)0x80000001 : 0x7fffffff;
    __syncthreads();
    bf16x8 afA[4][4];
    { const int P0 = c.vcu < 2048 ? c.vcu : 0; indexer_load_q(afA, QI, (size_t)(P0 >> 8) * SEQ, 8 * (P0 & 255)); }
    for (int P = c.vcu; P < 2048; P += c.G) {
        const int b = P >> 8, up = P & 255;
        const int tA = 8 * up, tB = 8 * (511 - up), ntA = (tA + 8 + 31) >> 5, ntB = (tB + 8 + 31) >> 5, offB = 32 * ntA;
        const size_t tokb = (size_t)b * SEQ;
        float loA[4], hiA[4], loB[4], hiB[4];
        indexer_scores(afA, KI, WI, tokb, tA, ntA, 0, sc, 0, loA, hiA, WVL, w);
        { bf16x8 afB[4][4]; indexer_load_q(afB, QI, tokb, tB);
          indexer_minmax(loA, hiA, mm);
          indexer_scores(afB, KI, WI, tokb, tB, ntB, ntA & 7, sc, offB, loB, hiB, WVL, w); }
        { const int Pn = (P + c.G < 2048) ? P + c.G : P; indexer_load_q(afA, QI, (size_t)(Pn >> 8) * SEQ, 8 * (Pn & 255)); }
        indexer_minmax(loB, hiB, mm + 16);
        __syncthreads();
        const float mnA = ord2f(mm[2 * w]), mxA = ord2f(mm[2 * w + 1]), mnB = ord2f(mm[16 + 2 * w]), mxB = ord2f(mm[16 + 2 * w + 1]);
        select_token(sc + w * IDX_ROWW, hist, cand, tA + w + 1, mnA, mxA, IDX + (tokb + tA + w) * 256, lane);
        select_token(sc + w * IDX_ROWW + offB, hist, cand, tB + w + 1, mnB, mxB, IDX + (tokb + tB + w) * 256, lane);
        __syncthreads();
        if (c.tid < 32) mm[c.tid] = (c.tid & 1) ? (int)0x80000001 : 0x7fffffff;
        __syncthreads();
    }
}

__device__ __forceinline__ void sparse_attn_phase(const Ctx& c0, unsigned char* ws) {
    const Ctx c = launder(c0);
    constexpr int RP = 592;
    bf16_t* OA = (bf16_t*)(ws + WS_OA); const bf16_t* QR = (const bf16_t*)(ws + WS_QR); const bf16_t* CKV = (const bf16_t*)(ws + WS_CKV);
    const unsigned short* IDX = (const unsigned short*)(ws + WS_IDX);
    LAS unsigned char* buf = c.lds + c.wave * (32 * RP);
    const int lane = c.lane, hd = lane & 15, g = lane >> 4, hi = lane >> 5;
    const float sc = 0.08838834764831845f * LOG2E;
    int id0n = (c.gw < MTOK) ? (int)((const GAS unsigned short*)IDX)[(size_t)c.gw * 256 + (lane & 31)] : 0;
    for (int tok = c.gw; tok < MTOK; tok += c.NGW) {
        const int b = tok >> 12, t = tok & 4095, nsel = t + 1 < 256 ? t + 1 : 256, nch = (nsel + 31) >> 5;
        bf16x8 qf[9];
        { int ln = lane_id(); asm volatile("" : "+v"(ln)); const int hq = ln & 15, gq = ln >> 4;
#pragma unroll
          for (int s = 0; s < 8; ++s) qf[s] = (hq < 8) ? *(const GAS bf16x8*)(OA + (size_t)tok * LDOA + hq * 256 + 32 * s + 8 * gq) : (bf16x8){0, 0, 0, 0, 0, 0, 0, 0};
          qf[8] = (hq < 8) ? *(const GAS bf16x8*)(QR + (size_t)tok * 256 + hq * 32 + 8 * gq) : (bf16x8){0, 0, 0, 0, 0, 0, 0, 0}; }
        float m = NEGBIG, l = 0.f; f32x4 O[16];
#pragma unroll
        for (int d = 0; d < 16; ++d) O[d] = (f32x4){0.f, 0.f, 0.f, 0.f};
        const bf16_t* ckb = CKV + (size_t)b * SEQ * CKVP;
#define SA_GATHER(id_) do { const GAS unsigned char* cb_ = (const GAS unsigned char*)ckb;                  \
        _Pragma("unroll") for (int i = 0; i < 16; ++i) { const unsigned ra = (unsigned)__builtin_amdgcn_readlane((id_), 2 * i), rb = (unsigned)__builtin_amdgcn_readlane((id_), 2 * i + 1); const unsigned r = hi ? rb : ra; \
            unsigned of_ = __umul24(r, 576u) + lo16_; asm volatile("" : "+v"(of_)); tmp[i] = *(const GAS u32x4*)(cb_ + of_); } \
        _Pragma("unroll") for (int i = 0; i < 2; ++i) { const unsigned r = (unsigned)__shfl((id_), 16 * i + (lane >> 2)); unsigned of_ = __umul24(r, 576u) + 512u + t16_; asm volatile("" : "+v"(of_)); tmp[16 + i] = *(const GAS u32x4*)(cb_ + of_); } } while (0)
        const unsigned lo16_ = (unsigned)(lane & 31) * 16u, t16_ = (unsigned)(lane & 3) * 16u;
        u32x4 tmp[18];
        const GAS unsigned short* idp = (const GAS unsigned short*)(IDX + (size_t)tok * 256 + (lane & 31));
        { const int id0 = id0n; SA_GATHER(id0); }
        { const int tn = tok + c.NGW < MTOK ? tok + c.NGW : tok; id0n = (int)((const GAS unsigned short*)IDX)[(size_t)tn * 256 + (lane & 31)]; }
        int nid = (int)idp[nch > 1 ? 32 : 0];
        for (int ch = 0; ch < nch; ++ch) {
            asm volatile("" ::: "memory");
#pragma unroll
            for (int i = 0; i < 16; ++i) *(LAS u32x4*)(buf + (2 * i + hi) * RP + (lane & 31) * 16) = tmp[i];
#pragma unroll
            for (int i = 0; i < 2; ++i) *(LAS u32x4*)(buf + (16 * i + (lane >> 2)) * RP + 512 + (lane & 3) * 16) = tmp[16 + i];
            asm volatile("" ::: "memory");
            { const int nid2 = (int)idp[32 * ((ch + 2 < nch) ? ch + 2 : nch - 1)]; if (ch + 1 < nch) { SA_GATHER(nid); } nid = nid2; }
            __builtin_amdgcn_s_setprio(1);
            f32x4 S0 = {0.f, 0.f, 0.f, 0.f}, S1 = {0.f, 0.f, 0.f, 0.f}, S0b = {0.f, 0.f, 0.f, 0.f}, S1b = {0.f, 0.f, 0.f, 0.f};
#pragma unroll
            for (int s = 0; s < 9; ++s) {
                const bf16x8 a0 = *(const LAS bf16x8*)(buf + hd * RP + (32 * s + 8 * g) * 2);
                const bf16x8 a1 = *(const LAS bf16x8*)(buf + (16 + hd) * RP + (32 * s + 8 * g) * 2);
                if (s & 1) { S0b = __builtin_amdgcn_mfma_f32_16x16x32_bf16(a0, qf[s], S0b, 0, 0, 0); S1b = __builtin_amdgcn_mfma_f32_16x16x32_bf16(a1, qf[s], S1b, 0, 0, 0); }
                else { S0 = __builtin_amdgcn_mfma_f32_16x16x32_bf16(a0, qf[s], S0, 0, 0, 0); S1 = __builtin_amdgcn_mfma_f32_16x16x32_bf16(a1, qf[s], S1, 0, 0, 0); }
            }
            __builtin_amdgcn_sched_group_barrier(0x100, 4, 0);
#pragma unroll
            for (int i = 0; i < 7; ++i) { __builtin_amdgcn_sched_group_barrier(0x008, 2, 0); __builtin_amdgcn_sched_group_barrier(0x100, 2, 0); }
            __builtin_amdgcn_sched_group_barrier(0x008, 4, 0);
            __builtin_amdgcn_s_setprio(0);
            S0 += S0b; S1 += S1b;
            float mt = NEGBIG;
            const int kb = 32 * ch + 4 * g;
#pragma unroll
            for (int r = 0; r < 4; ++r) { S0[r] = (kb + r < nsel) ? S0[r] : NEGBIG; S1[r] = (kb + 16 + r < nsel) ? S1[r] : NEGBIG; mt = fmaxf(mt, fmaxf(S0[r], S1[r])); }
            mt = xmax32(xmax16(mt)) * sc;
            const float mn = fmaxf(m, mt);
            if (__any(mn > m + 8.0f)) { const float al = fexp2(m - mn); l *= al;
#pragma unroll
                for (int d = 0; d < 16; ++d) O[d] *= al;
                m = mn; }
            float ps = 0.f;
#pragma unroll
            for (int r = 0; r < 4; ++r) { S0[r] = fexp2(__builtin_fmaf(S0[r], sc, -m)); S1[r] = fexp2(__builtin_fmaf(S1[r], sc, -m)); ps += S0[r] + S1[r]; }
            l += ps;
            u32x4 pw; pw.x = cvt_pk_bf16(S0[0], S0[1]); pw.y = cvt_pk_bf16(S0[2], S0[3]); pw.z = cvt_pk_bf16(S1[0], S1[1]); pw.w = cvt_pk_bf16(S1[2], S1[3]);
            const bf16x8 pf = __builtin_bit_cast(bf16x8, pw);
            {
                const int qq = (lane & 15) >> 2, pp = lane & 3;
                const LAS unsigned char* vb = buf + (4 * g + qq) * RP + (4 * pp) * 2;
                __builtin_amdgcn_s_setprio(1);
#pragma unroll
                for (int d = 0; d < 16; ++d) {
                    const s16x4 lo = __builtin_amdgcn_ds_read_tr16_b64_v4i16((LAS s16x4*)(vb + d * 32));
                    const s16x4 h4 = __builtin_amdgcn_ds_read_tr16_b64_v4i16((LAS s16x4*)(vb + 16 * RP + d * 32));
                    const bf16x8 vf = (bf16x8){lo[0], lo[1], lo[2], lo[3], h4[0], h4[1], h4[2], h4[3]};
                    O[d] = __builtin_amdgcn_mfma_f32_16x16x32_bf16(vf, pf, O[d], 0, 0, 0);
                }
                __builtin_amdgcn_sched_group_barrier(0x100, 4, 0);
#pragma unroll
                for (int i = 0; i < 14; ++i) { __builtin_amdgcn_sched_group_barrier(0x008, 1, 0); __builtin_amdgcn_sched_group_barrier(0x100, 2, 0); }
                __builtin_amdgcn_sched_group_barrier(0x008, 2, 0);
                __builtin_amdgcn_s_setprio(0);
            }
        }
        l = xsum32(xsum16(l));
        const float il = 1.0f / l;
        { int lo_ = lane_id(); asm volatile("" : "+v"(lo_));
          asm volatile("" ::: "memory");
          if ((lo_ & 15) < 8) {
              LAS unsigned char* sp = buf + (lo_ & 15) * 528 + 8 * (lo_ >> 4);
#pragma unroll
              for (int d = 0; d < 16; ++d) { u32x2 w; w.x = cvt_pk_bf16(O[d][0] * il, O[d][1] * il); w.y = cvt_pk_bf16(O[d][2] * il, O[d][3] * il); *(LAS u32x2*)(sp + 32 * d) = w; }
          }
          asm volatile("" ::: "memory");
          bf16_t* o = OA + (size_t)tok * LDOA + (lo_ >> 5) * 256 + (lo_ & 31) * 8;
#pragma unroll
          for (int i = 0; i < 4; ++i) { const u32x4 v = *(const LAS u32x4*)(buf + (2 * i + (lo_ >> 5)) * 528 + (lo_ & 31) * 16); *(GAS u32x4*)(o + i * 512) = v; }
          asm volatile("" ::: "memory"); }
    }
}

#undef SA_GATHER
__device__ __forceinline__ void glu_phase(const Ctx& c0, unsigned char* ws, const float* cw, const float* cb) {
    const Ctx c = launder(c0);
    const bf16_t* AH = (const bf16_t*)(ws + WS_AH); bf16_t* BH = (bf16_t*)(ws + WS_BH);
    const int gt = c.gw * 64 + c.lane, NGT = c.NGW * 64;
    constexpr int CV = FF / 8;
    for (int i = gt; i < 16384 * CV; i += NGT) {
        const int r = i / CV, cv = i % CV, col = cv * 8, t = r & 4095;
        const u32x4 a0 = *(const GAS u32x4*)(AH + (size_t)r * FF + col);
        const u32x4 a1 = (t >= 1) ? *(const GAS u32x4*)(AH + (size_t)(r - 1) * FF + col) : (u32x4){0u, 0u, 0u, 0u};
        const u32x4 a2 = (t >= 2) ? *(const GAS u32x4*)(AH + (size_t)(r - 2) * FF + col) : (u32x4){0u, 0u, 0u, 0u};
        const u32x4 bb = *(const GAS u32x4*)(BH + (size_t)r * FF + col);
        float w0[8], w1[8], w2[8], bi[8];
#pragma unroll
        for (int e = 0; e < 2; ++e) { const f32x4 x0 = *(const GAS f32x4*)(cw + col + 4 * e), x1 = *(const GAS f32x4*)(cw + FF + col + 4 * e), x2 = *(const GAS f32x4*)(cw + 2 * FF + col + 4 * e), x3 = *(const GAS f32x4*)(cb + col + 4 * e);
#pragma unroll
            for (int q = 0; q < 4; ++q) { w0[4 * e + q] = x0[q]; w1[4 * e + q] = x1[q]; w2[4 * e + q] = x2[q]; bi[4 * e + q] = x3[q]; } }
        u32x4 o;
#pragma unroll
        for (int e = 0; e < 4; ++e) {
            const float c0 = w0[2 * e] * bflo(a2[e]) + w1[2 * e] * bflo(a1[e]) + w2[2 * e] * bflo(a0[e]) + bi[2 * e];
            const float c1 = w0[2 * e + 1] * bfhi(a2[e]) + w1[2 * e + 1] * bfhi(a1[e]) + w2[2 * e + 1] * bfhi(a0[e]) + bi[2 * e + 1];
            const float g0 = c0 * __builtin_amdgcn_rcpf(1.0f + fexp2(-c0 * LOG2E)) * bflo(bb[e]);
            const float g1 = c1 * __builtin_amdgcn_rcpf(1.0f + fexp2(-c1 * LOG2E)) * bfhi(bb[e]);
            o[e] = cvt_pk_bf16(g0, g1);
        }
        *(GAS u32x4*)(BH + (size_t)r * FF + col) = o;
    }
}

__global__ void __launch_bounds__(NTHR, 2) fwd_kernel(Args a_unused) {
    extern __shared__ __attribute__((aligned(16))) unsigned char lds_raw[];
    Ctx c;
    c.lds = (LAS unsigned char*)lds_raw;
    c.tid = threadIdx.x; c.lane = c.tid & 63; c.wave = __builtin_amdgcn_readfirstlane(c.tid >> 6);
    c.G = gridDim.x; { const int bx = blockIdx.x; c.vcu = (c.G % 8 == 0) ? (bx % 8) * (c.G / 8) + bx / 8 : bx; }
    c.gw = c.vcu * NWAVES + c.wave; c.NGW = c.G * NWAVES;
    volatile LAS unsigned* MISC = (volatile LAS unsigned*)(c.lds + MISC_OFF);
    if (c.tid < 32) MISC[c.tid] = 0u;
    __syncthreads();
    unsigned char* ws = gptr(argp()->ws);
    XcdBarrier bar = xcd_barrier_post((unsigned*)(ws + WS_CTL) + CW_BAR, MISC + 8); bar.wave = c.wave;
    int ph = 0;
    const int lo = argp()->ph_lo, hi = argp()->ph_hi;
#define PHASE_BEGIN if (ph >= lo && ph < hi) {
#define PHASE_END   if (ph + 1 < hi) xcd_barrier(bar); } ++ph;

    PHASE_BEGIN prologue1(c); PHASE_END
    PHASE_BEGIN prologue2(c, ws); PHASE_END

#pragma nounroll
    for (int l = 0; l < DEPTH; ++l) {
        asm volatile("" : "+s"(ws)); ws = gptr(ws);
        const int kind = l % 3, j = l / 3;
        unsigned char* wl = ws + WS_WT + (size_t)l * WT_LAYER;
        const bf16_t* kvm = (const bf16_t*)(ws + WS_KVM + (size_t)l * 2 * MiB);
        PHASE_BEGIN
        { const int N = kind == 0 ? NA_IN : kind == 1 ? NB_IN : NC_IN;
          pg8::Gemm g{(const bf16_t*)(ws + WS_XN), (const bf16_t*)(wl + WT_IN), DM, DM, DM}; pg8::StaticOrder S; S.init(MTOK, N, c.G, (int)blockIdx.x);
          EpiIn E{kind, ws, (const float*)(ws + WS_SSP)}; pg8::gemm_phase<EpiIn, pg8::StaticOrder>(c.lds, g, S, E, c.wave); }
        PHASE_END
        if (kind == 0) {
            PHASE_BEGIN
            ckv_norm_rows(c, ws, gptr(argp()->a_kv_norm) + (size_t)j * 256);
            mem_attn_units(c, (bf16_t*)(ws + WS_OA), LDOA, 2048, kvm);
            __syncthreads();
            indexer_phase(c, ws);
            PHASE_END
            PHASE_BEGIN sparse_attn_phase(c, ws); PHASE_END
        } else if (kind == 1) {
            PHASE_BEGIN
            mem_attn_units(c, (bf16_t*)(ws + WS_OB), LDOB, 1024, kvm);
            swa_units(c, ws, gptr(argp()->b_sinks) + (size_t)j * 16);
            PHASE_END
        } else {
            PHASE_BEGIN
            mem_attn_units(c, (bf16_t*)(ws + WS_OC), LDOB, 1024, kvm);
            dil_units(c, ws, (bf16_t*)gptr(argp()->out), 0, 2);
            PHASE_END
            PHASE_BEGIN dil_units(c, ws, (bf16_t*)gptr(argp()->out), 2, 3); PHASE_END
        }
        PHASE_BEGIN
        { const int K = kind == 0 ? LDOA : LDOB;
          pg8::Gemm g{(const bf16_t*)(ws + WS_ACT), (const bf16_t*)(wl + WT_OUT), K, K, K}; pg8::StaticOrder S; S.init(MTOK, DM, c.G, (int)blockIdx.x);
          EpiRes E{(bf16_t*)(ws + WS_XN), (float*)(ws + WS_SSP)}; pg8::gemm_phase<EpiRes, pg8::StaticOrder>(c.lds, g, S, E, c.wave); }
        PHASE_END
        PHASE_BEGIN
        { pg8::Gemm g{(const bf16_t*)(ws + WS_XN), (const bf16_t*)(wl + WT_UP), DM, DM, DM}; pg8::OvlOrder S; S.init(BATCH * 17, 22, c.G, (int)blockIdx.x);
          EpiGlu E{(bf16_t*)(ws + WS_G), (const float*)(ws + WS_SSP), gptr(argp()->f_conv_w) + (size_t)l * 3 * FF, gptr(argp()->f_conv_b) + (size_t)l * FF};
          pg8::gemm_phase<EpiGlu, pg8::OvlOrder>(c.lds, g, S, E, c.wave); }
        PHASE_END
        PHASE_BEGIN
        { pg8::Gemm g{(const bf16_t*)(ws + WS_G), (const bf16_t*)(wl + WT_DOWN), FF, FF, FF}; pg8::StaticOrder S; S.init(MTOK, DM, c.G, (int)blockIdx.x);
          EpiRes E{(bf16_t*)(ws + WS_XN), (float*)(ws + WS_SSP)}; pg8::gemm_phase<EpiRes, pg8::StaticOrder>(c.lds, g, S, E, c.wave); }
        PHASE_END
    }
    if (ph >= lo && ph < hi) final_norm_phase(c, (const bf16_t*)(ws + WS_XN), (const float*)(ws + WS_SSP), gptr(argp()->g_final), gptr(argp()->out));
#undef PHASE_BEGIN
#undef PHASE_END
}

extern "C" void kernel_launch(void* const* d_in, const int* in_sizes, int n_in, void* d_out, int out_size, void* d_ws, size_t ws_size, hipStream_t stream) {
    static int grid = 0;
    if (grid == 0) {
        if (n_in != 22 || ws_size < WS_END) { fprintf(stderr, "kernel_launch: unexpected n_in %d or ws_size %zu\n", n_in, ws_size); grid = -1; return; }
        int dev = 0, cus = 0, per_cu = 0;
        if (hipGetDevice(&dev) != hipSuccess || hipDeviceGetAttribute(&cus, hipDeviceAttributeMultiprocessorCount, dev) != hipSuccess) { grid = -1; return; }
        if (hipFuncSetAttribute((const void*)fwd_kernel, hipFuncAttributeMaxDynamicSharedMemorySize, LDS_BYTES) != hipSuccess) { fprintf(stderr, "kernel_launch: hipFuncSetAttribute failed\n"); grid = -1; return; }
        if (hipOccupancyMaxActiveBlocksPerMultiprocessor(&per_cu, (const void*)fwd_kernel, NTHR, LDS_BYTES) != hipSuccess || per_cu < 1)
            fprintf(stderr, "kernel_launch: occupancy query reports %d\n", per_cu);
        (void)hipGetLastError();
        grid = cus;
    }
    if (grid < 0) return;
    (void)hipMemsetAsync((char*)d_ws + WS_CTL, 0, CTL_ZERO_BYTES, stream);
    Args a{};
    a.x = (const float*)d_in[0]; a.mem = (const float*)d_in[1]; a.positions = (const int*)d_in[2];
    a.g_mix = (const float*)d_in[3]; a.g_ffn = (const float*)d_in[4]; a.g_mem = (const float*)d_in[5]; a.g_final = (const float*)d_in[6]; a.w_mem_kv = (const float*)d_in[7];
    a.a_w_in = (const float*)d_in[8]; a.a_kv_norm = (const float*)d_in[9]; a.a_w_uk = (const float*)d_in[10]; a.a_w_uv = (const float*)d_in[11]; a.a_w_out = (const float*)d_in[12];
    a.b_w_in = (const float*)d_in[13]; a.b_sinks = (const float*)d_in[14]; a.b_w_out = (const float*)d_in[15]; a.c_w_in = (const float*)d_in[16]; a.c_w_out = (const float*)d_in[17];
    a.f_w_up = (const float*)d_in[18]; a.f_conv_w = (const float*)d_in[19]; a.f_conv_b = (const float*)d_in[20]; a.f_w_down = (const float*)d_in[21];
    a.out = (float*)d_out; a.ws = (unsigned char*)d_ws;
    a.ph_lo = 0; a.ph_hi = 1000;
    hipLaunchKernelGGL(fwd_kernel, dim3(grid), dim3(NTHR), LDS_BYTES, stream, a);
}
```

```cpp
#include <hip/hip_runtime.h>
#include <cstdio>
#include <cstdint>
#include <cmath>

#define LAS __attribute__((address_space(3)))
#define GAS __attribute__((address_space(1)))
typedef unsigned short bf16_t;
typedef short bf16x8 __attribute__((ext_vector_type(8)));
typedef short s16x4 __attribute__((ext_vector_type(4)));
typedef float f32x4 __attribute__((ext_vector_type(4)));
typedef float f32x2 __attribute__((ext_vector_type(2)));
typedef float f32x16 __attribute__((ext_vector_type(16)));
typedef unsigned u32x4 __attribute__((ext_vector_type(4)));
typedef unsigned u32x2 __attribute__((ext_vector_type(2)));
typedef GAS unsigned gu32;

constexpr int BATCH = 8, SEQ = 4096, DM = 1024, MTOK = BATCH * SEQ, DEPTH = 4, FF = 2816, MEMLEN = 256;
constexpr int NWAVES = 8, NTHR = 512;
constexpr float EPS = 1e-6f;
constexpr float LOG2E = 1.4426950408889634f;
constexpr float NEGBIG = -1e30f;
constexpr float MASKV = -3.0e38f;
constexpr int NA_IN = 4096, NB_IN = 1792, NC_IN = 3328;
constexpr int LDOA = 2304, LDOB = 1280;
constexpr int CKVP = 288;

constexpr size_t MiB = 1u << 20;
constexpr size_t WS_CTL = 0, CTL_ZERO_BYTES = 1 * MiB;
constexpr size_t WS_COS32 = 1 * MiB, WS_SIN32 = 3 * MiB, WS_COS16 = 5 * MiB, WS_SIN16 = 6 * MiB;
constexpr size_t WS_MEMN = 7 * MiB;
constexpr size_t WS_KVM = 11 * MiB;
constexpr size_t WS_WT = 20 * MiB, WT_LAYER = 32 * MiB;
constexpr size_t WT_UP = 0, WT_DOWN = 11 * MiB, WT_MKV = 17 * MiB, WT_OUT = 18 * MiB, WT_IN = 23 * MiB;
constexpr size_t WS_XN = 148 * MiB;
constexpr size_t WS_ACT = 212 * MiB;
constexpr size_t WS_OA = WS_ACT, WS_QR = WS_ACT + 144 * MiB, WS_CKV = WS_ACT + 160 * MiB, WS_KI = WS_ACT + 178 * MiB, WS_WI = WS_ACT + 182 * MiB,
                 WS_QI = WS_ACT + 184 * MiB, WS_IDX = WS_ACT + 248 * MiB, WS_TMP = WS_ACT + 264 * MiB;
constexpr size_t WS_OB = WS_ACT, WS_KB = WS_ACT + 80 * MiB, WS_VB = WS_ACT + 96 * MiB;
constexpr size_t WS_OC = WS_ACT, WS_KC = WS_ACT + 80 * MiB, WS_VC = WS_ACT + 144 * MiB, WS_P2 = WS_ACT + 208 * MiB, WS_LSE = WS_ACT + 272 * MiB;
constexpr size_t WS_AH = WS_ACT, WS_BH = WS_ACT + 88 * MiB;
constexpr size_t WS_G = WS_ACT;
constexpr size_t WS_SSP = 508 * MiB;
constexpr size_t WS_END = 512 * MiB;
constexpr size_t TMP_STRIDE = 16 * MiB, TMP_WNAT = 0, TMP_WUKT = 6 * MiB, TMP_WUVN = 7 * MiB, TMP_WOT = 8 * MiB;

constexpr int CW_TMO = 0, CW_BAR = 4096;

constexpr int LDS_BYTES = 159744;
constexpr int MISC_OFF = 155648;

__device__ __forceinline__ unsigned f2bf(float f) { unsigned u = __builtin_bit_cast(unsigned, f); return (u + 0x7fffu + ((u >> 16) & 1u)) >> 16; }
__device__ __forceinline__ unsigned cvt_pk_bf16(float lo, float hi) { unsigned r; asm volatile("v_cvt_pk_bf16_f32 %0, %1, %2" : "=v"(r) : "v"(lo), "v"(hi)); return r; }
__device__ __forceinline__ float bf2f(unsigned short b) { return __builtin_bit_cast(float, (unsigned)b << 16); }
__device__ __forceinline__ float bflo(unsigned w) { return __builtin_bit_cast(float, w << 16); }
__device__ __forceinline__ float bfhi(unsigned w) { return __builtin_bit_cast(float, w & 0xffff0000u); }
__device__ __forceinline__ float wave_max(float v) {
#pragma unroll
    for (int o = 1; o < 64; o <<= 1) v = fmaxf(v, __shfl_xor(v, o));
    return v;
}
__device__ __forceinline__ float wave_min(float v) {
#pragma unroll
    for (int o = 1; o < 64; o <<= 1) v = fminf(v, __shfl_xor(v, o));
    return v;
}
__device__ __forceinline__ float fexp2(float x) { return __builtin_amdgcn_exp2f(x); }
__device__ __forceinline__ float xmax16(float v) { const unsigned u = __builtin_bit_cast(unsigned, v); const auto r = __builtin_amdgcn_permlane16_swap(u, u, false, false); const unsigned r0 = r[0], r1 = r[1]; const float a = __builtin_bit_cast(float, r0), b = __builtin_bit_cast(float, r1); return fmaxf(a, b); }
__device__ __forceinline__ float xmax32(float v) { const unsigned u = __builtin_bit_cast(unsigned, v); const auto r = __builtin_amdgcn_permlane32_swap(u, u, false, false); const unsigned r0 = r[0], r1 = r[1]; const float a = __builtin_bit_cast(float, r0), b = __builtin_bit_cast(float, r1); return fmaxf(a, b); }
__device__ __forceinline__ float xsum16(float v) { const unsigned u = __builtin_bit_cast(unsigned, v); const auto r = __builtin_amdgcn_permlane16_swap(u, u, false, false); const unsigned r0 = r[0], r1 = r[1]; const float a = __builtin_bit_cast(float, r0), b = __builtin_bit_cast(float, r1); return a + b; }
__device__ __forceinline__ float xsum32(float v) { const unsigned u = __builtin_bit_cast(unsigned, v); const auto r = __builtin_amdgcn_permlane32_swap(u, u, false, false); const unsigned r0 = r[0], r1 = r[1]; const float a = __builtin_bit_cast(float, r0), b = __builtin_bit_cast(float, r1); return a + b; }
__device__ __forceinline__ float wave_sum(float v) {
    v += __builtin_bit_cast(float, __builtin_amdgcn_mov_dpp(__builtin_bit_cast(int, v), 0xB1, 0xf, 0xf, false));
    v += __builtin_bit_cast(float, __builtin_amdgcn_mov_dpp(__builtin_bit_cast(int, v), 0x4E, 0xf, 0xf, false));
    v += __builtin_bit_cast(float, __builtin_amdgcn_mov_dpp(__builtin_bit_cast(int, v), 0x141, 0xf, 0xf, false));
    v += __builtin_bit_cast(float, __builtin_amdgcn_mov_dpp(__builtin_bit_cast(int, v), 0x140, 0xf, 0xf, false));
    return xsum32(xsum16(v));
}
#define DPPF(v_, ctl_) __builtin_bit_cast(float, __builtin_amdgcn_mov_dpp(__builtin_bit_cast(int, (v_)), (ctl_), 0xf, 0xf, false))
__device__ __forceinline__ float half_min(float v) {
    v = fminf(v, DPPF(v, 0xB1)); v = fminf(v, DPPF(v, 0x4E)); v = fminf(v, DPPF(v, 0x141)); v = fminf(v, DPPF(v, 0x140));
    const unsigned u = __builtin_bit_cast(unsigned, v); const auto r = __builtin_amdgcn_permlane16_swap(u, u, false, false); const unsigned r0 = r[0], r1 = r[1];
    return fminf(__builtin_bit_cast(float, r0), __builtin_bit_cast(float, r1));
}
__device__ __forceinline__ float half_max(float v) {
    v = fmaxf(v, DPPF(v, 0xB1)); v = fmaxf(v, DPPF(v, 0x4E)); v = fmaxf(v, DPPF(v, 0x141)); v = fmaxf(v, DPPF(v, 0x140));
    return xmax16(v);
}
__device__ __forceinline__ int crow(int r, int hi) { return (r & 3) + 8 * (r >> 2) + 4 * hi; }

#define XB_TMO      128
#define XB_XCNT(j)  (256  + 64 * (j))
#define XB_XSUB(j)  (1280 + 64 * (j))
#define XB_XGEN(j)  (2304 + 64 * (j))
#define XB_TOP      3328
#define XB_TOPGEN   3392
#define XCD_BAR_WORDS 3456
#define XB_SPIN_CAP (1u << 22)

__device__ __forceinline__ unsigned xb_ld(unsigned* p)              { return __hip_atomic_load(p, __ATOMIC_RELAXED, __HIP_MEMORY_SCOPE_AGENT); }
__device__ __forceinline__ unsigned xb_add(unsigned* p, unsigned v) { return __hip_atomic_fetch_add(p, v, __ATOMIC_RELAXED, __HIP_MEMORY_SCOPE_AGENT); }
__device__ __forceinline__ unsigned xb_xcc_id() { return (unsigned)__builtin_amdgcn_s_getreg((3 << 11) | 20) & 0xFu; }
#define XB_SPIN(cond, bar) do { unsigned _sp = 0; while (cond) { __builtin_amdgcn_s_sleep(1); \
    if ((++_sp & 255u) == 0u) { if (xb_ld(&(bar)[XB_TMO])) break; if (_sp > XB_SPIN_CAP) { atomicAdd(&(bar)[XB_TMO], 1u); break; } } } } while (0)

struct XcdBarrier { unsigned* bar; unsigned x; volatile LAS unsigned* st; int wave; };

__device__ __forceinline__ XcdBarrier xcd_barrier_post(unsigned* bar, volatile LAS unsigned* st) {
    XcdBarrier b; b.bar = bar; b.x = xb_xcc_id(); b.st = st;
    if (threadIdx.x == 0) (void)xb_add(&bar[XB_XCNT(b.x)], 1u);
    return b;
}
__device__ __forceinline__ void xcd_barrier_complete(unsigned* bar, unsigned x, unsigned& nloc, unsigned& nx) {
    const unsigned G = gridDim.x * gridDim.y * gridDim.z;
    unsigned sum, cnt, mine, sp = 0u;
    for (;;) {
        sum = 0u; cnt = 0u; mine = 0u;
#pragma unroll
        for (unsigned j = 0; j < 16; ++j) { const unsigned c = xb_ld(&bar[XB_XCNT(j)]); sum += c; cnt += (c > 0u) ? 1u : 0u; mine = (j == x) ? c : mine; }
        if (sum == G) break;
        __builtin_amdgcn_s_sleep(1);
        if ((++sp & 255u) == 0u) { if (xb_ld(&bar[XB_TMO])) break; if (sp > XB_SPIN_CAP) { atomicAdd(&bar[XB_TMO], 1u); break; } }
    }
    nloc = mine > 0u ? mine : 1u; nx = cnt > 0u ? cnt : 1u;
}
__device__ __forceinline__ void xcd_barrier(const XcdBarrier& b) {
    asm volatile("s_waitcnt vmcnt(0)" ::: "memory");
    __syncthreads();
    int bl_; asm volatile("v_mbcnt_lo_u32_b32 %0, -1, 0\n\tv_mbcnt_hi_u32_b32 %0, -1, %0" : "=v"(bl_));
    if (b.wave == 0 && bl_ == 0) {
        unsigned* bar = b.bar;
        __builtin_amdgcn_s_waitcnt(0);
        unsigned nloc = b.st[0], nx = b.st[1];
        if (nloc == 0u) { xcd_barrier_complete(bar, b.x, nloc, nx); b.st[0] = nloc; b.st[1] = nx; }
        const unsigned old = xb_add(&bar[XB_XSUB(b.x)], 1u);
        const unsigned gen = old / nloc;
        if (old + 1u == (gen + 1u) * nloc) {
            __builtin_amdgcn_fence(__ATOMIC_RELEASE, "agent");
            asm volatile("s_waitcnt vmcnt(0)" ::: "memory");
            const unsigned og = xb_add(&bar[XB_TOP], 1u);
            const unsigned tg = og / nx;
            if (og + 1u == (tg + 1u) * nx) xb_add(&bar[XB_TOPGEN], 1u);
            else XB_SPIN(xb_ld(&bar[XB_TOPGEN]) == tg, bar);
            __builtin_amdgcn_fence(__ATOMIC_ACQUIRE, "agent");
            xb_add(&bar[XB_XGEN(b.x)], 1u);
            asm volatile("s_waitcnt vmcnt(0)" ::: "memory");
        } else {
            XB_SPIN(xb_ld(&bar[XB_XGEN(b.x)]) == gen, bar);
            __builtin_amdgcn_fence(__ATOMIC_ACQUIRE, "agent");
            asm volatile("s_waitcnt vmcnt(0)" ::: "memory");
        }
    }
    __syncthreads();
}

namespace pg8 {
constexpr int BM = 256, BK = 64, HALF = 128, HTB = HALF * BK * 2, STAGE_BYTES = 8 * HTB, NXCD = 8, WGM = 8;
__device__ __forceinline__ int lds_byte(int r, int c) { const int st = (r >> 4) * 2 + (c >> 5), rr = r & 15, cc = c & 31, ob = rr * 64 + cc * 2; return st * 1024 + (ob ^ (((ob >> 9) & 1) << 5)); }
__device__ __forceinline__ void stage_rc(int b, int& R, int& C) { const int st = b / 1024, sb = b % 1024, swz = sb ^ (((sb >> 9) & 1) << 5); R = (st >> 1) * 16 + swz / 64; C = (st & 1) * 32 + (swz % 64) / 2; }
__device__ __forceinline__ int perm32(int rho) { const int n = rho >> 4, i = rho & 15; return 8 * (i >> 2) + 4 * n + (i & 3); }

struct Unit { int pm, pn; };
struct Gemm { const bf16_t* A; const bf16_t* Bt; int lda, ldb, K; };

struct StaticOrder {
    static constexpr bool OVL = false;
    int nM, nN, nwg, G, c;
    __device__ __forceinline__ long arow(const Unit& u) const { return (long)u.pm * BM; }
    __device__ void init(int M, int N, int G_, int c_) { nM = M / BM; nN = N / BM; nwg = nM * nN; G = G_; c = c_; }
    __device__ bool next(int i, Unit& u) const {
        const long L = (long)i * G + c; if (L >= nwg) return false;
        int wgid = (int)L; { const int q = nwg / NXCD, r = nwg % NXCD, xcd = wgid % NXCD, off = wgid / NXCD; wgid = (xcd < r ? xcd * (q + 1) : r * (q + 1) + (xcd - r) * q) + off; }
        const int nig = WGM * nN, gid = wgid / nig, fm = gid * WGM, gsz = (nM - fm) < WGM ? (nM - fm) : WGM;
        u.pm = fm + ((wgid % nig) % gsz); u.pn = (wgid % nig) / gsz; return true;
    }
};
struct OvlOrder {
    static constexpr bool OVL = true;
    int nM, nN, nwg, G, c;
    __device__ void init(int nM_, int nN_, int G_, int c_) { nM = nM_; nN = nN_; nwg = nM * nN; G = G_; c = c_; }
    __device__ bool next(int i, Unit& u) const {
        const long L = (long)i * G + c; if (L >= nwg) return false;
        int wgid = (int)L; { const int q = nwg / NXCD, r = nwg % NXCD, xcd = wgid % NXCD, off = wgid / NXCD; wgid = (xcd < r ? xcd * (q + 1) : r * (q + 1) + (xcd - r) * q) + off; }
        const int nig = WGM * nN, gid = wgid / nig, fm = gid * WGM, gsz = (nM - fm) < WGM ? (nM - fm) : WGM;
        u.pm = fm + ((wgid % nig) % gsz); u.pn = (wgid % nig) / gsz; return true;
    }
    __device__ __forceinline__ long arow(const Unit& u) const { return (long)(u.pm / 17) * 4096 + 248 * (u.pm % 17) - 2; }
};
struct OneUnit {
    static constexpr bool OVL = false;
    __device__ __forceinline__ long arow(const Unit& u) const { return (long)u.pm * BM; }
    int pm, pn; bool have;
    __device__ bool next(int i, Unit& u) const { if (i > 0 || !have) return false; u.pm = pm; u.pn = pn; return true; }
};

template <class Epi, class Sched>
__device__ __forceinline__ void gemm_phase(LAS unsigned char* lds, const Gemm g, const Sched& S, const Epi& E, int wave_) {
    int tid_; asm volatile("v_mbcnt_lo_u32_b32 %0, -1, 0\n\tv_mbcnt_hi_u32_b32 %0, -1, %0" : "=v"(tid_)); tid_ += wave_ * 64;
    const int tid = tid_, wid = __builtin_amdgcn_readfirstlane(tid >> 6), lane = tid & 63, wr = wid >> 2, wc = wid & 3, fr = lane & 15, fq = lane >> 4;
    const int K = g.K, nt = K / BK;
    unsigned voffA[2], voffB[2];
#pragma unroll
    for (int i = 0; i < 2; ++i) { int R, C; stage_rc(tid * 16 + i * 8192, R, C); const int Rb = Epi::PERM ? ((R & ~31) + perm32(R & 31)) : R;
        const int Ra = Sched::OVL ? 62 * (R >> 6) + 4 * (R & 15) + ((R >> 4) & 3) : R;
        voffA[i] = (unsigned)(Ra * g.lda + C) * 2u; voffB[i] = (unsigned)(Rb * g.ldb + C) * 2u; }
    const size_t kstep = (size_t)(BK * 2);
    const size_t hstepA = (size_t)(Sched::OVL ? HALF - 4 : HALF) * g.lda * 2, hstepB = (size_t)HALF * g.ldb * 2;
    const size_t tstepB = 2 * hstepB; const long rowbA = (long)g.lda * 2;
    const unsigned ldsw = (unsigned)wid * 1024u;
    const int aoff = lds_byte(wr * 64 + fr, fq * 8), boff = lds_byte(wc * 32 + fr, fq * 8);
#define PG8_SA(b, h) (((b) * 2 + (h)) * HTB)
#define PG8_SB(b, h) ((4 + (b) * 2 + (h)) * HTB)
#define PG8_STAGE(bufoff, gbase, voff) do { _Pragma("unroll") for (int _i = 0; _i < 2; ++_i) \
        __builtin_amdgcn_global_load_lds((const unsigned*)((const char*)(gbase) + (voff)[_i]), (LAS unsigned*)(lds + (bufoff) + ldsw + _i * 8192), 16, 0, 0); } while (0)
#define PG8_LDA(dst, b, h) do { _Pragma("unroll") for (int m = 0; m < 4; ++m) _Pragma("unroll") for (int k = 0; k < 2; ++k) dst[m][k] = *(const LAS bf16x8*)(lds + PG8_SA(b, h) + aoff + m * 2048 + k * 1024); } while (0)
#define PG8_LDB(dst, b, h) do { _Pragma("unroll") for (int n = 0; n < 2; ++n) _Pragma("unroll") for (int k = 0; k < 2; ++k) dst[n][k] = *(const LAS bf16x8*)(lds + PG8_SB(b, h) + boff + n * 2048 + k * 1024); } while (0)
#define PG8_MMA(ai, bj, At, Bt) do { __builtin_amdgcn_s_setprio(1); _Pragma("unroll") for (int m = 0; m < 4; ++m) _Pragma("unroll") for (int n = 0; n < 2; ++n) _Pragma("unroll") for (int k = 0; k < 2; ++k) \
        acc[ai][bj][m][n] = __builtin_amdgcn_mfma_f32_16x16x32_bf16(Bt[n][k], At[m][k], acc[ai][bj][m][n], 0, 0, 0); __builtin_amdgcn_s_setprio(0); } while (0)
#define PG8_WAIT_V(n) asm volatile("s_waitcnt vmcnt(" #n ")" ::: "memory")
#define PG8_WAIT_L(n) asm volatile("s_waitcnt lgkmcnt(" #n ")" ::: "memory")
#define PG8_BAR __builtin_amdgcn_s_barrier()
#define PG8_SCHED __builtin_amdgcn_sched_barrier(0)
    Unit cur, nxt; int ui = 0;
    if (!S.next(0, cur)) return;
    f32x4 acc[2][2][4][2];
#pragma unroll
    for (int a = 0; a < 2; ++a)
#pragma unroll
        for (int b = 0; b < 2; ++b)
#pragma unroll
            for (int m = 0; m < 4; ++m)
#pragma unroll
                for (int n = 0; n < 2; ++n) acc[a][b][m][n] = (f32x4){0.f, 0.f, 0.f, 0.f};
    bf16x8 At[4][2], B0[2][2], B1[2][2];
    const char* cA = (const char*)g.A + S.arow(cur) * rowbA; const char* cB = (const char*)g.Bt + (size_t)cur.pn * tstepB;
    PG8_STAGE(PG8_SB(0, 0), cB, voffB); PG8_STAGE(PG8_SB(0, 1), cB + hstepB, voffB); PG8_STAGE(PG8_SA(0, 0), cA, voffA); PG8_STAGE(PG8_SA(0, 1), cA + hstepA, voffA);
    if (wr == 1) PG8_BAR;
    PG8_WAIT_V(2); PG8_BAR;
    PG8_STAGE(PG8_SB(1, 0), cB + kstep, voffB); PG8_STAGE(PG8_SA(1, 0), cA + kstep, voffA); PG8_STAGE(PG8_SB(1, 1), cB + hstepB + kstep, voffB);
    PG8_WAIT_V(6); PG8_BAR;
    for (;;) {
        const bool has_next = S.next(ui + 1, nxt);
        if constexpr (Epi::PREFETCH) { PG8_BAR; E.prefetch(lds + 8 * HTB, S.arow(cur), cur, wid, lane); }
        const char* nA = has_next ? (const char*)g.A + S.arow(nxt) * rowbA : cA; const char* nB = has_next ? (const char*)g.Bt + (size_t)nxt.pn * tstepB : cB;
        for (int t = 0; t < nt; t += 2) {
            const bool last = (t == nt - 2);
            const char* a1 = cA + (size_t)(t + 1) * kstep;
            const char* a2 = last ? nA : cA + (size_t)(t + 2) * kstep; const char* b2 = last ? nB : cB + (size_t)(t + 2) * kstep;
            const char* a3 = a2 + kstep; const char* b3 = b2 + kstep;
            PG8_LDB(B0, 0, 0); PG8_LDB(B1, 0, 1); PG8_SCHED; PG8_LDA(At, 0, 0); PG8_STAGE(PG8_SA(1, 1), a1 + hstepA, voffA);
            PG8_WAIT_V(8); PG8_WAIT_L(0); PG8_BAR; PG8_MMA(0, 0, At, B0); PG8_MMA(0, 1, At, B1); PG8_BAR; PG8_SCHED;
            PG8_LDA(At, 0, 1); PG8_STAGE(PG8_SB(0, 0), b2, voffB); PG8_STAGE(PG8_SB(0, 1), b2 + hstepB, voffB); PG8_STAGE(PG8_SA(0, 0), a2, voffA);
            PG8_WAIT_V(8); PG8_WAIT_L(0); PG8_BAR; PG8_MMA(1, 0, At, B0); PG8_MMA(1, 1, At, B1); PG8_BAR; PG8_SCHED;
            PG8_LDB(B0, 1, 0); PG8_LDB(B1, 1, 1); PG8_SCHED; PG8_LDA(At, 1, 0); PG8_STAGE(PG8_SA(0, 1), a2 + hstepA, voffA);
            PG8_WAIT_V(8); PG8_WAIT_L(0); PG8_BAR; PG8_MMA(0, 0, At, B0); PG8_MMA(0, 1, At, B1); PG8_BAR; PG8_SCHED;
            PG8_LDA(At, 1, 1); PG8_STAGE(PG8_SB(1, 0), b3, voffB); PG8_STAGE(PG8_SB(1, 1), b3 + hstepB, voffB); PG8_STAGE(PG8_SA(1, 0), a3, voffA);
            PG8_WAIT_V(8); PG8_WAIT_L(0); PG8_BAR; PG8_MMA(1, 0, At, B0); PG8_MMA(1, 1, At, B1); PG8_BAR; PG8_SCHED;
        }
        if (wr == 0) PG8_BAR;
        E(acc, cur, wr, wc, fr, fq);
        if (!has_next) break;
#pragma unroll
        for (int a = 0; a < 2; ++a)
#pragma unroll
            for (int b = 0; b < 2; ++b)
#pragma unroll
                for (int m = 0; m < 4; ++m)
#pragma unroll
                    for (int n = 0; n < 2; ++n) acc[a][b][m][n] = (f32x4){0.f, 0.f, 0.f, 0.f};
        cur = nxt; cA = nA; cB = nB; ++ui;
        if (wr == 1) PG8_BAR;
    }
    PG8_WAIT_V(0);
    PG8_BAR;
#undef PG8_SA
#undef PG8_SB
#undef PG8_STAGE
#undef PG8_LDA
#undef PG8_LDB
#undef PG8_MMA
#undef PG8_WAIT_V
#undef PG8_WAIT_L
#undef PG8_BAR
#undef PG8_SCHED
}
}

struct EpiPlain {
    static constexpr bool PREFETCH = false;
    static constexpr bool PERM = true;
    bf16_t* O; bf16_t* O2; int ldc; int split;
    __device__ __forceinline__ void operator()(const f32x4 (&acc)[2][2][4][2], const pg8::Unit& u, int wr, int wc, int fr, int fq) const {
        bf16_t* base = (u.pn < split) ? O + u.pn * 256 : O2 + (u.pn - split) * 256;
        const int row0 = u.pm * 256 + wr * 64 + fr, col0 = wc * 32 + 8 * fq;
#pragma unroll
        for (int ai = 0; ai < 2; ++ai)
#pragma unroll
            for (int m = 0; m < 4; ++m) { bf16_t* rowp = base + (size_t)(row0 + ai * 128 + m * 16) * ldc + col0;
#pragma unroll
                for (int bj = 0; bj < 2; ++bj) { const f32x4 v0 = acc[ai][bj][m][0], v1 = acc[ai][bj][m][1];
                    u32x4 w; w.x = cvt_pk_bf16(v0[0], v0[1]); w.y = cvt_pk_bf16(v0[2], v0[3]); w.z = cvt_pk_bf16(v1[0], v1[1]); w.w = cvt_pk_bf16(v1[2], v1[3]);
                    *(GAS u32x4*)(rowp + bj * 128) = w; } }
    }
};
struct EpiRes {
    static constexpr bool PREFETCH = false;
    static constexpr bool PERM = true;
    bf16_t* xb; float* ssp;
    __device__ __forceinline__ void operator()(const f32x4 (&acc)[2][2][4][2], const pg8::Unit& u, int wr, int wc, int fr, int fq) const {
        const int row0 = u.pm * 256 + wr * 64 + fr, col0 = u.pn * 256 + wc * 32 + 8 * fq;
        u32x4 xo[2][4][2];
#pragma unroll
        for (int ai = 0; ai < 2; ++ai)
#pragma unroll
            for (int m = 0; m < 4; ++m)
#pragma unroll
                for (int bj = 0; bj < 2; ++bj) xo[ai][m][bj] = *(const GAS u32x4*)(xb + (size_t)(row0 + ai * 128 + m * 16) * DM + col0 + bj * 128);
        __builtin_amdgcn_sched_barrier(0);
#pragma unroll
        for (int ai = 0; ai < 2; ++ai)
#pragma unroll
            for (int m = 0; m < 4; ++m) { const int row = row0 + ai * 128 + m * 16; const size_t off = (size_t)row * DM + col0; float ss = 0.f;
#pragma unroll
                for (int bj = 0; bj < 2; ++bj) { const u32x4 bw = xo[ai][m][bj]; const f32x4 a0 = acc[ai][bj][m][0], a1 = acc[ai][bj][m][1];
                    u32x4 w; w.x = cvt_pk_bf16(bflo(bw.x) + a0[0], bfhi(bw.x) + a0[1]); w.y = cvt_pk_bf16(bflo(bw.y) + a0[2], bfhi(bw.y) + a0[3]);
                    w.z = cvt_pk_bf16(bflo(bw.z) + a1[0], bfhi(bw.z) + a1[1]); w.w = cvt_pk_bf16(bflo(bw.w) + a1[2], bfhi(bw.w) + a1[3]);
                    *(GAS u32x4*)(xb + off + bj * 128) = w;
#pragma unroll
                    for (int e = 0; e < 4; ++e) { const float v0 = bflo(w[e]), v1 = bfhi(w[e]); ss += v0 * v0 + v1 * v1; } }
                ss = xsum32(xsum16(ss));
                if (fq == 0) ((GAS float*)ssp)[(size_t)row * 16 + u.pn * 4 + wc] = ss; }
    }
};
__device__ __forceinline__ float row_rstd(const float* ssp, long row) {
    const GAS f32x4* sp = (const GAS f32x4*)(ssp + row * 16); const f32x4 s0 = sp[0], s1 = sp[1], s2 = sp[2], s3 = sp[3];
    const float ss = ((s0[0] + s0[1]) + (s0[2] + s0[3])) + ((s1[0] + s1[1]) + (s1[2] + s1[3])) + ((s2[0] + s2[1]) + (s2[2] + s2[3])) + ((s3[0] + s3[1]) + (s3[2] + s3[3]));
    return __builtin_amdgcn_rsqf(ss * (1.f / DM) + EPS);
}
__device__ __forceinline__ float row_rstd_q(const float* ssp, long row, int fq) {
    const f32x4 s = ((const GAS f32x4*)(ssp + row * 16))[fq];
    const float ss = xsum32(xsum16((s[0] + s[1]) + (s[2] + s[3])));
    return __builtin_amdgcn_rsqf(ss * (1.f / DM) + EPS);
}
__device__ __forceinline__ float rstd_from_q(const f32x4 s) { const float ss = xsum32(xsum16((s[0] + s[1]) + (s[2] + s[3]))); return __builtin_amdgcn_rsqf(ss * (1.f / DM) + EPS); }
template <int SH> __device__ __forceinline__ float row_shift(float cur, float prv) {
    const int t = __builtin_amdgcn_mov_dpp(__builtin_bit_cast(int, prv), 0x120 + SH, 0xf, 0xf, false);
    const int r = __builtin_amdgcn_update_dpp(t, __builtin_bit_cast(int, cur), 0x110 + SH, 0xf, 0xf, false);
    return __builtin_bit_cast(float, r);
}
template <int SH> __device__ __forceinline__ float row_shift0(float cur) {
    return __builtin_bit_cast(float, __builtin_amdgcn_update_dpp(0, __builtin_bit_cast(int, cur), 0x110 + SH, 0xf, 0xf, true));
}
struct EpiGlu {
    static constexpr bool PERM = true;
    static constexpr bool PREFETCH = true;
    bf16_t* G; const float* ssp; const float* cw; const float* cb;
    __device__ __forceinline__ void prefetch(LAS unsigned char* sp, long arow, const pg8::Unit& u, int wid, int lane_) const {
        int lane; asm volatile("v_mbcnt_lo_u32_b32 %0, -1, 0\n\tv_mbcnt_hi_u32_b32 %0, -1, %0" : "=v"(lane));
#pragma unroll
        for (int i = 0; i < 2; ++i) { long gr = arow + wid * 32 + 16 * i + (lane >> 2); gr = gr < 0 ? 0 : (gr < MTOK ? gr : MTOK - 1);
            __builtin_amdgcn_global_load_lds((const GAS unsigned*)(ssp + gr * 16 + (lane & 3) * 4), (LAS unsigned*)(sp + wid * 2048 + i * 1024), 16, 0, 0); }
        if (wid < 2) { const int q = wid * 64 + lane, a_ = q >> 5, c4 = q & 31; const float* src = (a_ < 3 ? cw + (size_t)a_ * FF : cb) + 128 * u.pn + 4 * c4;
            __builtin_amdgcn_global_load_lds((const GAS unsigned*)src, (LAS unsigned*)(sp + 16384 + wid * 1024), 16, 0, 0); }
    }
    LAS unsigned char* sp_;
    __device__ __forceinline__ void operator()(const f32x4 (&acc)[2][2][4][2], const pg8::Unit& u, int wr, int wc, int fr, int fq) const {
        const int b = u.pm / 17, jj = u.pm % 17, ch0 = 128 * u.pn + 32 * wc + 8 * fq;
        f32x4 w0[2], w1[2], w2[2], bi[2];
        asm volatile("" ::: "memory");
        int ln_; asm volatile("v_mbcnt_lo_u32_b32 %0, -1, 0\n\tv_mbcnt_hi_u32_b32 %0, -1, %0" : "=v"(ln_)); const int fr_ = ln_ & 15, fq_ = ln_ >> 4;
        { const LAS f32x4* wl = (const LAS f32x4*)(sp_ + 16384) + 8 * wc + 2 * fq_;
#pragma unroll
          for (int n = 0; n < 2; ++n) { w0[n] = wl[n]; w1[n] = wl[32 + n]; w2[n] = wl[64 + n]; bi[n] = wl[96 + n]; } }
        float rsa[2][4];
        { f32x4 pq[8];
#pragma unroll
          for (int k = 0; k < 8; ++k) pq[k] = *(const LAS f32x4*)(sp_ + (62 * (2 * (k >> 2) + wr) + 4 * fr_ + (k & 3)) * 64 + fq_ * 16);
          __builtin_amdgcn_sched_barrier(0);
#pragma unroll
          for (int k = 0; k < 8; ++k) { const int t = 248 * jj + 62 * (2 * (k >> 2) + wr) - 2 + 4 * fr + (k & 3); const float r_ = rstd_from_q(pq[k]); rsa[k >> 2][k & 3] = (t >= 0) ? r_ : 0.f; } }
#pragma unroll
        for (int ai = 0; ai < 2; ++ai) {
            const int t0 = 248 * jj + 62 * (2 * ai + wr) - 2 + 4 * fr;
            float rs[4];
#pragma unroll
            for (int m = 0; m < 4; ++m) rs[m] = rsa[ai][m];
            u32x2 gp[4];
#pragma unroll
            for (int n = 0; n < 2; ++n) {
                f32x4 av[4];
#pragma unroll
                for (int m = 0; m < 4; ++m) { av[m] = acc[ai][0][m][n] * rs[m];
                    if (ai == 0 && m < 2) { if (t0 + m < 0) av[m] = (f32x4){0.f, 0.f, 0.f, 0.f}; } }
                f32x4 s3, s2;
#pragma unroll
                for (int e = 0; e < 4; ++e) { s3[e] = row_shift0<1>(av[3][e]); s2[e] = row_shift0<1>(av[2][e]); }
#pragma unroll
                for (int m = 0; m < 4; ++m) {
                    const f32x4 a1 = m == 0 ? s3 : av[m == 0 ? 0 : m - 1], a2 = m == 0 ? s2 : m == 1 ? s3 : av[m < 2 ? 0 : m - 2];
                    f32x4 gv;
#pragma unroll
                    for (int e = 0; e < 4; ++e) {
                        const float cv = __builtin_fmaf(w2[n][e], av[m][e], __builtin_fmaf(w1[n][e], a1[e], __builtin_fmaf(w0[n][e], a2[e], bi[n][e])));
                        gv[e] = (cv * __builtin_amdgcn_rcpf(1.0f + fexp2(cv * -LOG2E))) * (acc[ai][1][m][n][e] * rs[m]); }
                    if (n == 0) { gp[m].x = cvt_pk_bf16(gv[0], gv[1]); gp[m].y = cvt_pk_bf16(gv[2], gv[3]); }
                    else { const int t = t0 + m;
                        if ((fr > 0 || m >= 2) && t < SEQ) { u32x4 w; w.x = gp[m].x; w.y = gp[m].y; w.z = cvt_pk_bf16(gv[0], gv[1]); w.w = cvt_pk_bf16(gv[2], gv[3]);
                            *(GAS u32x4*)(G + (size_t)((long)b * SEQ + t) * FF + ch0) = w; } }
                }
            }
        }
    }
};
struct EpiIn {
    static constexpr bool PERM = true;
    static constexpr bool PREFETCH = true;
    __device__ __forceinline__ void prefetch(LAS unsigned char* sp, long arow, const pg8::Unit& u, int wid, int lane_) const {
        int lane; asm volatile("v_mbcnt_lo_u32_b32 %0, -1, 0\n\tv_mbcnt_hi_u32_b32 %0, -1, %0" : "=v"(lane));
#pragma unroll
        for (int i = 0; i < 2; ++i) { const long gr = arow + wid * 32 + 16 * i + (lane >> 2);
            __builtin_amdgcn_global_load_lds((const GAS unsigned*)(ssp + gr * 16 + (lane & 3) * 4), (LAS unsigned*)(sp + wid * 2048 + i * 1024), 16, 0, 0); }
    }
    int kind;
    unsigned char* ws;
    LAS unsigned char* sp_;
    const float* ssp;
    __device__ __forceinline__ void operator()(f32x4 (&acc)[2][2][4][2], const pg8::Unit& u, int wr, int wc, int fr, int fq) const {
        bf16_t* dst; int ld; int mode = 0; const int pn = u.pn;
        if (kind == 0) {
            if (pn < 8) { dst = (bf16_t*)(ws + WS_OA) + pn * 256; ld = LDOA; }
            else if (pn == 8) { dst = (bf16_t*)(ws + WS_QR); ld = 256; mode = 3; }
            else if (pn == 9) { dst = (bf16_t*)(ws + WS_CKV); ld = CKVP; }
            else if (pn == 10) { dst = (bf16_t*)(ws + WS_CKV) + 256; ld = CKVP; mode = 4; }
            else if (pn < 15) { dst = (bf16_t*)(ws + WS_QI) + (pn - 11) * 256; ld = 1024; mode = 2; }
            else { dst = (bf16_t*)(ws + WS_OA) + 2048; ld = LDOA; }
        } else if (kind == 1) {
            if (pn < 4) { dst = (bf16_t*)(ws + WS_OB) + pn * 256; ld = LDOB; mode = 2; }
            else if (pn == 4) { dst = (bf16_t*)(ws + WS_KB); ld = 256; mode = 2; }
            else if (pn == 5) { dst = (bf16_t*)(ws + WS_VB); ld = 256; }
            else { dst = (bf16_t*)(ws + WS_OB) + 1024; ld = LDOB; }
        } else {
            if (pn < 4) { dst = (bf16_t*)(ws + WS_OC) + pn * 256; ld = LDOB; mode = 1; }
            else if (pn < 8) { dst = (bf16_t*)(ws + WS_KC) + (pn - 4) * 256; ld = 1024; mode = 1; }
            else if (pn < 12) { dst = (bf16_t*)(ws + WS_VC) + (pn - 8) * 256; ld = 1024; }
            else { dst = (bf16_t*)(ws + WS_OC) + 1024; ld = LDOB; }
        }
        const int row0 = u.pm * 256 + wr * 64 + fr;
        asm volatile("" ::: "memory");
        { f32x4 pq[8];
          int ln_; asm volatile("v_mbcnt_lo_u32_b32 %0, -1, 0\n\tv_mbcnt_hi_u32_b32 %0, -1, %0" : "=v"(ln_)); const int fr_ = ln_ & 15, fq_ = ln_ >> 4;
#pragma unroll
          for (int k = 0; k < 8; ++k) pq[k] = *(const LAS f32x4*)(sp_ + (wr * 64 + fr_ + (k >> 2) * 128 + (k & 3) * 16) * 64 + fq_ * 16);
          __builtin_amdgcn_sched_barrier(0);
#pragma unroll
          for (int k = 0; k < 8; ++k) { const float rs = rstd_from_q(pq[k]);
#pragma unroll
              for (int bj = 0; bj < 2; ++bj)
#pragma unroll
                  for (int n = 0; n < 2; ++n) acc[k >> 2][bj][k & 3][n] *= rs; } }
        const bool r32 = (mode == 1 && wc == 0) || mode == 3 || (mode == 4 && wc == 0);
        const bool r16 = (mode == 2 && (wc & 1) == 0) || (mode == 4 && wc == 1);
        if (r32 || r16) {
            const int xl = r32 ? 32 : 16;
            const bool second = r32 ? (fq >= 2) : (fq & 1);
            const float* ct = (const float*)(ws + (r32 ? WS_COS32 : WS_COS16)); const float* st = (const float*)(ws + (r32 ? WS_SIN32 : WS_SIN16));
            const int tw = r32 ? 16 : 8, i0 = r32 ? 8 * (fq & 1) : 0;
            const int nbj = (mode == 4) ? 1 : 2;
#define EI_TAB(k_, c0_, c1_, s0_, s1_) do { const int row_ = row0 + ((k_) >> 2) * 128 + ((k_) & 3) * 16; \
                c0_ = *(const GAS f32x4*)(ct + (size_t)row_ * tw + i0); c1_ = *(const GAS f32x4*)(ct + (size_t)row_ * tw + i0 + 4); \
                s0_ = *(const GAS f32x4*)(st + (size_t)row_ * tw + i0); s1_ = *(const GAS f32x4*)(st + (size_t)row_ * tw + i0 + 4); } while (0)
            f32x4 nc0, nc1, ns0, ns1; EI_TAB(0, nc0, nc1, ns0, ns1);
            const bool act = r32 ? true : (fq < 2);
#pragma unroll
            for (int k = 0; k < 8; ++k) {
                const f32x4 c0 = nc0, c1 = nc1, s0 = ns0, s1 = ns1;
                if (k < 7) { EI_TAB(k + 1, nc0, nc1, ns0, ns1); }
                __builtin_amdgcn_sched_barrier(0);
                const int ai = k >> 2, m = k & 3;
#pragma unroll
                for (int bj = 0; bj < 2; ++bj) { if (bj < nbj) {
#pragma unroll
                    for (int n = 0; n < 2; ++n) { f32x4 v = acc[ai][bj][m][n]; const f32x4 cc = n ? c1 : c0, ss = n ? s1 : s0; f32x4 o;
#pragma unroll
                        for (int e = 0; e < 4; ++e) { const float p = __shfl_xor(v[e], xl); o[e] = second ? (v[e] * cc[e] + p * ss[e]) : (v[e] * cc[e] - p * ss[e]); }
                        if (act) acc[ai][bj][m][n] = o; } } }
            }
#undef EI_TAB
        }
        if (mode != 4) {
            const int col0 = wc * 32 + 8 * fq;
#pragma unroll
            for (int ai = 0; ai < 2; ++ai)
#pragma unroll
                for (int m = 0; m < 4; ++m) { bf16_t* rowp = dst + (size_t)(row0 + ai * 128 + m * 16) * ld + col0;
#pragma unroll
                    for (int bj = 0; bj < 2; ++bj) { const f32x4 v0 = acc[ai][bj][m][0], v1 = acc[ai][bj][m][1];
                        u32x4 w; w.x = cvt_pk_bf16(v0[0], v0[1]); w.y = cvt_pk_bf16(v0[2], v0[3]); w.z = cvt_pk_bf16(v1[0], v1[1]); w.w = cvt_pk_bf16(v1[2], v1[3]);
                        *(GAS u32x4*)(rowp + bj * 128) = w; } }
        } else {
            bf16_t* KI = (bf16_t*)(ws + WS_KI); float* WI = (float*)(ws + WS_WI);
#pragma unroll
            for (int ai = 0; ai < 2; ++ai)
#pragma unroll
                for (int m = 0; m < 4; ++m) { const size_t row = (size_t)(row0 + ai * 128 + m * 16); const f32x4 v0 = acc[ai][0][m][0], v1 = acc[ai][0][m][1];
                    u32x4 w; w.x = cvt_pk_bf16(v0[0], v0[1]); w.y = cvt_pk_bf16(v0[2], v0[3]); w.z = cvt_pk_bf16(v1[0], v1[1]); w.w = cvt_pk_bf16(v1[2], v1[3]);
                    if (wc == 0) *(GAS u32x4*)(dst + row * CKVP + 8 * fq) = w;
                    else if (wc < 3) *(GAS u32x4*)(KI + row * 64 + (wc - 1) * 32 + 8 * fq) = w;
                    else if (fq < 2) { *(GAS f32x4*)(WI + row * 16 + 8 * fq) = v0 * 0.03125f; *(GAS f32x4*)(WI + row * 16 + 8 * fq + 4) = v1 * 0.03125f; } }
        }
    }
};

struct Args {
    const float* x; const float* mem; const int* positions;
    const float* g_mix; const float* g_ffn; const float* g_mem; const float* g_final; const float* w_mem_kv;
    const float* a_w_in; const float* a_kv_norm; const float* a_w_uk; const float* a_w_uv; const float* a_w_out;
    const float* b_w_in; const float* b_sinks; const float* b_w_out; const float* c_w_in; const float* c_w_out;
    const float* f_w_up; const float* f_conv_w; const float* f_conv_b; const float* f_w_down;
    float* out; unsigned char* ws;
    int ph_lo, ph_hi;
};

template <class T> __device__ __forceinline__ T* gptr(T* p) { return (T*)(GAS T*)p; }
typedef const __attribute__((address_space(4))) Args* ArgP;
__device__ __forceinline__ ArgP argp() { ArgP p = (ArgP)__builtin_amdgcn_kernarg_segment_ptr(); asm volatile("" : "+s"(p)); return p; }
struct Ctx { LAS unsigned char* lds; int tid, lane, wave, vcu, G, gw, NGW; };
__device__ __forceinline__ int lane_id() { int l; asm volatile("v_mbcnt_lo_u32_b32 %0, -1, 0\n\tv_mbcnt_hi_u32_b32 %0, -1, %0" : "=v"(l)); return l; }
__device__ __forceinline__ Ctx launder(Ctx c) { int l = lane_id(); asm volatile("" : "+v"(l)); c.lane = l; c.tid = c.wave * 64 + l;
    asm volatile("" : "+s"(c.wave), "+s"(c.vcu), "+s"(c.gw)); return c; }

__device__ __forceinline__ void transpose_job(const Ctx& c, int& base, const float* W, int ldw, int k_org, int n_org, int Ksub, int Nsub, bf16_t* WT, int ldt, int koff, const float* gain = nullptr) {
    LAS float* scr = (LAS float*)(c.lds + c.wave * 16384);
    const int nblk = Nsub / 32, nitems = (Ksub / 64) * nblk, lane = c.lane;
    int start = (c.gw - (base % c.NGW) + c.NGW) % c.NGW; base += nitems;
    if (start >= nitems) return;
    const int ch = lane & 7;
    float v[32]; f32x4 g0 = {1.f, 1.f, 1.f, 1.f}, g1 = {1.f, 1.f, 1.f, 1.f};
#define TJ_LOAD(it_) do { const int kb_ = (it_) / nblk, nb_ = (it_) % nblk; const float* wp_ = W + (size_t)(k_org + 64 * kb_ + (lane >> 5)) * ldw + n_org + 32 * nb_ + (lane & 31); \
        _Pragma("unroll") for (int i = 0; i < 32; ++i) v[i] = ((const GAS float*)wp_)[(size_t)(2 * i) * ldw]; \
        if (gain) { g0 = *(const GAS f32x4*)(gain + k_org + 64 * kb_ + 8 * ch); g1 = *(const GAS f32x4*)(gain + k_org + 64 * kb_ + 8 * ch + 4); } } while (0)
    TJ_LOAD(start);
    for (int it = start; it < nitems; it += c.NGW) {
        const int kb = it / nblk, nb = it % nblk, k0 = 64 * kb, n0 = 32 * nb;
#pragma unroll
        for (int i = 0; i < 32; ++i) scr[(2 * i + (lane >> 5)) * 33 + (lane & 31)] = v[i];
        const f32x4 h0 = g0, h1 = g1;
        asm volatile("s_waitcnt lgkmcnt(0)" ::: "memory");
        if (it + c.NGW < nitems) { TJ_LOAD(it + c.NGW); }
#pragma unroll
        for (int j = 0; j < 4; ++j) { const int n = (lane >> 3) + 8 * j; const LAS float* sp = scr + (8 * ch) * 33 + n;
            u32x4 o; o.x = cvt_pk_bf16(sp[0 * 33] * h0[0], sp[1 * 33] * h0[1]); o.y = cvt_pk_bf16(sp[2 * 33] * h0[2], sp[3 * 33] * h0[3]); o.z = cvt_pk_bf16(sp[4 * 33] * h1[0], sp[5 * 33] * h1[1]); o.w = cvt_pk_bf16(sp[6 * 33] * h1[2], sp[7 * 33] * h1[3]);
            *(GAS u32x4*)(WT + (size_t)(n0 + n) * ldt + koff + k0 + 8 * ch) = o; }
        asm volatile("s_waitcnt lgkmcnt(0)" ::: "memory");
    }
#undef TJ_LOAD
}
__device__ __forceinline__ void rms_row_bf16(const float* xrow, const float* gain, bf16_t* orow, int lane) {
    const f32x4* xr = (const f32x4*)xrow + lane; const f32x4* gr = (const f32x4*)gain + lane;
    f32x4 v[4]; float s = 0.f;
#pragma unroll
    for (int j = 0; j < 4; ++j) { v[j] = xr[64 * j]; s += (v[j].x * v[j].x + v[j].y * v[j].y) + (v[j].z * v[j].z + v[j].w * v[j].w); }
    const float rstd = 1.0f / sqrtf(wave_sum(s) * (1.f / DM) + EPS);
    u32x2* o8 = (u32x2*)orow + lane;
#pragma unroll
    for (int j = 0; j < 4; ++j) { const f32x4 gg = gr[64 * j]; u32x2 w; w.x = cvt_pk_bf16(v[j].x * rstd * gg.x, v[j].y * rstd * gg.y); w.y = cvt_pk_bf16(v[j].z * rstd * gg.z, v[j].w * rstd * gg.w); o8[64 * j] = w; }
}
__device__ __forceinline__ void rms_rows_phase(const Ctx& c0, const float* x, const float* gain, bf16_t* xn, int nrows) {
    const Ctx c = launder(c0);
    for (int m = c.gw; m < nrows; m += c.NGW) rms_row_bf16(x + (size_t)m * DM, gain, xn + (size_t)m * DM, c.lane);
}
__device__ __forceinline__ void final_norm_phase(const Ctx& c0, const bf16_t* xb, const float* ssp, const float* gain, float* out) {
    const Ctx c = launder(c0);
    f32x4 gg[4];
#pragma unroll
    for (int j = 0; j < 4; ++j) gg[j] = ((const GAS f32x4*)gain + c.lane)[64 * j];
    for (int m = c.gw; m < MTOK; m += c.NGW) {
        const GAS u32x2* xr = (const GAS u32x2*)(xb + (size_t)m * DM) + c.lane; f32x4* o = (f32x4*)(out + (size_t)m * DM) + c.lane;
        u32x2 w[4];
#pragma unroll
        for (int j = 0; j < 4; ++j) w[j] = xr[64 * j];
        const float rstd = row_rstd(ssp, m);
#pragma unroll
        for (int j = 0; j < 4; ++j) o[64 * j] = (f32x4){bflo(w[j].x) * rstd * gg[j].x, bfhi(w[j].x) * rstd * gg[j].y, bflo(w[j].y) * rstd * gg[j].z, bfhi(w[j].y) * rstd * gg[j].w};
    }
}
__device__ __forceinline__ void prologue1(const Ctx& c0) {
    const Ctx c = launder(c0);
    ArgP ap = argp();
#define a (*ap)
    unsigned char* ws = gptr(a.ws);
    const int gt = c.gw * 64 + c.lane, NGT = c.NGW * 64;
    int base = 0;
#pragma nounroll
    for (int l = 0; l < DEPTH; ++l) {
        const int kind = l % 3, j = l / 3;
        unsigned char* wl = ws + WS_WT + (size_t)l * WT_LAYER;
        const float* gm = gptr(a.g_mix) + (size_t)l * DM; const float* gf = gptr(a.g_ffn) + (size_t)l * DM;
#pragma nounroll
        for (int pn = 0; pn < 22; ++pn) {
            transpose_job(c, base, gptr(a.f_w_up) + (size_t)l * DM * 2 * FF, 2 * FF, 0, 128 * pn, DM, 128, (bf16_t*)(wl + WT_UP) + (size_t)(256 * pn) * DM, DM, 0, gf);
            transpose_job(c, base, gptr(a.f_w_up) + (size_t)l * DM * 2 * FF, 2 * FF, 0, FF + 128 * pn, DM, 128, (bf16_t*)(wl + WT_UP) + (size_t)(256 * pn + 128) * DM, DM, 0, gf);
        }
        transpose_job(c, base, gptr(a.f_w_down) + (size_t)l * FF * DM, DM, 0, 0, FF, DM, (bf16_t*)(wl + WT_DOWN), FF, 0);
        transpose_job(c, base, gptr(a.w_mem_kv) + (size_t)l * DM * 512, 512, 0, 0, DM, 512, (bf16_t*)(wl + WT_MKV), DM, 0);
        if (kind == 1) {
            transpose_job(c, base, gptr(a.b_w_out), DM, 0, 0, 1280, DM, (bf16_t*)(wl + WT_OUT), 1280, 0);
            transpose_job(c, base, gptr(a.b_w_in), NB_IN, 0, 0, DM, NB_IN, (bf16_t*)(wl + WT_IN), DM, 0, gm);
        } else if (kind == 2) {
            transpose_job(c, base, gptr(a.c_w_out), DM, 0, 0, 1280, DM, (bf16_t*)(wl + WT_OUT), 1280, 0);
            transpose_job(c, base, gptr(a.c_w_in), NC_IN, 0, 0, DM, NC_IN, (bf16_t*)(wl + WT_IN), DM, 0, gm);
        } else {
            const float* win = gptr(a.a_w_in) + (size_t)j * DM * 2672; const float* wout = gptr(a.a_w_out) + (size_t)j * 1280 * DM;
            unsigned char* tmp = ws + WS_TMP + (size_t)j * TMP_STRIDE;
            bf16_t* wit = (bf16_t*)(wl + WT_IN);
            transpose_job(c, base, wout, DM, 0, 0, 1280, DM, (bf16_t*)(tmp + TMP_WOT), 1280, 0);
            transpose_job(c, base, wout, DM, 1024, 0, 256, DM, (bf16_t*)(wl + WT_OUT), LDOA, 2048);
#pragma nounroll
            for (int h = 0; h < 8; ++h) transpose_job(c, base, win, 2672, 0, h * 128, DM, 32, wit + (size_t)(2048 + 32 * h) * DM, DM, 0, gm);
            transpose_job(c, base, win, 2672, 0, 1024, DM, 256, wit + (size_t)2304 * DM, DM, 0, gm);
            transpose_job(c, base, win, 2672, 0, 1280, DM, 32, wit + (size_t)2560 * DM, DM, 0, gm);
            transpose_job(c, base, win, 2672, 0, 2336, DM, 96, wit + (size_t)2592 * DM, DM, 0, gm);
            transpose_job(c, base, win, 2672, 0, 1312, DM, 1024, wit + (size_t)2816 * DM, DM, 0, gm);
            transpose_job(c, base, win, 2672, 0, 2416, DM, 256, wit + (size_t)3840 * DM, DM, 0, gm);
            { u32x4* z = (u32x4*)(wit + (size_t)2688 * DM); for (int i = gt; i < 128 * DM / 8; i += NGT) z[i] = (u32x4){0u, 0u, 0u, 0u}; }
            { const GAS f32x4* s = (const GAS f32x4*)win; u32x2* d = (u32x2*)(tmp + TMP_WNAT); constexpr int NQ = DM * 2672 / 4;
              for (int i0 = gt; i0 < NQ; i0 += 3 * NGT) { f32x4 v[3]; float g[3];
#pragma unroll
                  for (int u = 0; u < 3; ++u) { const int i = i0 + u * NGT < NQ ? i0 + u * NGT : i0; v[u] = s[i]; g[u] = ((const GAS float*)gm)[i / 668]; }
#pragma unroll
                  for (int u = 0; u < 3; ++u) { const int i = i0 + u * NGT; if (i < NQ) { const f32x4 q = v[u] * g[u]; u32x2 w; w.x = cvt_pk_bf16(q.x, q.y); w.y = cvt_pk_bf16(q.z, q.w); d[i] = w; } } } }
            { const GAS f32x4* s = (const GAS f32x4*)(gptr(a.a_w_uv) + (size_t)j * 256 * 1024); u32x2* d = (u32x2*)(tmp + TMP_WUVN); constexpr int NQ = 256 * 1024 / 4;
              for (int i0 = gt; i0 < NQ; i0 += 2 * NGT) { f32x4 v[2];
#pragma unroll
                  for (int u = 0; u < 2; ++u) { const int i = i0 + u * NGT < NQ ? i0 + u * NGT : i0; v[u] = s[i]; }
#pragma unroll
                  for (int u = 0; u < 2; ++u) { const int i = i0 + u * NGT; if (i < NQ) { u32x2 w; w.x = cvt_pk_bf16(v[u].x, v[u].y); w.y = cvt_pk_bf16(v[u].z, v[u].w); d[i] = w; } } } }
            { const float* s = gptr(a.a_w_uk) + (size_t)j * 256 * 8 * 96; bf16_t* d = (bf16_t*)(tmp + TMP_WUKT);
              for (int i = gt; i < 8 * 256 * 128; i += NGT) { const int n = i & 127, r = (i >> 7) & 255, h = i >> 15; d[i] = (bf16_t)(n < 96 ? f2bf(s[((size_t)r * 8 + h) * 96 + n]) : 0u); } }
        }
    }
    { float* c32 = (float*)(ws + WS_COS32); float* s32 = (float*)(ws + WS_SIN32); float* c16 = (float*)(ws + WS_COS16); float* s16 = (float*)(ws + WS_SIN16);
      for (int i = gt; i < MTOK * 24; i += NGT) { const int row = i / 24, k = i % 24; const float pos = (float)gptr(a.positions)[row];
          const float ex = (k < 16) ? (float)k * (-1.0f / 16.0f) : (float)(k - 16) * (-1.0f / 8.0f); const float inv = exp2f(ex * 18.931568569324174f); const float ang = pos * inv;
          const double ad = (double)ang; const double kk = rint(ad * 0.15915494309189535); const float r = (float)(ad - kk * 6.283185307179586);
          const float cs = __cosf(r), sn = __sinf(r);
          if (k < 16) { c32[row * 16 + k] = cs; s32[row * 16 + k] = sn; } else { c16[row * 8 + k - 16] = cs; s16[row * 8 + k - 16] = sn; } } }
    rms_rows_phase(c, gptr(a.mem), gptr(a.g_mem), (bf16_t*)(ws + WS_MEMN), BATCH * MEMLEN);
    { bf16_t* xb = (bf16_t*)(ws + WS_XN); float* ssp = (float*)(ws + WS_SSP);
      for (int m0 = c.gw; m0 < MTOK; m0 += 2 * c.NGW) {
          f32x4 v[2][4];
#pragma unroll
          for (int r = 0; r < 2; ++r) { const int m = m0 + r * c.NGW < MTOK ? m0 + r * c.NGW : m0; const GAS f32x4* xr = (const GAS f32x4*)(gptr(a.x) + (size_t)m * DM) + c.lane;
#pragma unroll
              for (int jq = 0; jq < 4; ++jq) v[r][jq] = xr[64 * jq]; }
          __builtin_amdgcn_sched_barrier(0);
#pragma unroll
          for (int r = 0; r < 2; ++r) { const int m = m0 + r * c.NGW; if (m < MTOK) { u32x2* o8 = (u32x2*)(xb + (size_t)m * DM) + c.lane; float s2 = 0.f;
#pragma unroll
              for (int jq = 0; jq < 4; ++jq) { const f32x4 q = v[r][jq]; s2 += (q.x * q.x + q.y * q.y) + (q.z * q.z + q.w * q.w); u32x2 w; w.x = cvt_pk_bf16(q.x, q.y); w.y = cvt_pk_bf16(q.z, q.w); o8[64 * jq] = w; }
              s2 = wave_sum(s2); if (c.lane < 16) ssp[(size_t)m * 16 + c.lane] = (c.lane == 0) ? s2 : 0.f; } } } }
}

#undef a
__device__ __forceinline__ void prologue2(const Ctx& c0, unsigned char* ws) {
    const Ctx c = launder(c0);
    for (int w = blockIdx.x; w < 192; w += c.G) {
        pg8::Gemm g; pg8::OneUnit S; EpiPlain E; S.have = true; E.O2 = nullptr; E.split = 1 << 30;
        if (w < 128) {
            const int j = w >> 6, r = w & 63; unsigned char* tmp = ws + WS_TMP + (size_t)j * TMP_STRIDE; unsigned char* wl = ws + WS_WT + (size_t)(3 * j) * WT_LAYER;
            if (r < 32) { const int h = r >> 2, pn = r & 3;
                g.A = (const bf16_t*)(tmp + TMP_WUKT) + (size_t)h * 256 * 128; g.lda = 128; g.Bt = (const bf16_t*)(tmp + TMP_WNAT) + h * 128 + 32; g.ldb = 2672; g.K = 128;
                S.pm = 0; S.pn = pn; E.O = (bf16_t*)(wl + WT_IN) + (size_t)h * 256 * DM; E.ldc = DM;
            } else { const int h = (r - 32) >> 2, pm = (r - 32) & 3;
                g.A = (const bf16_t*)(tmp + TMP_WOT) + h * 128; g.lda = 1280; g.Bt = (const bf16_t*)(tmp + TMP_WUVN) + h * 128; g.ldb = 1024; g.K = 128;
                S.pm = pm; S.pn = 0; E.O = (bf16_t*)(wl + WT_OUT) + h * 256; E.ldc = LDOA;
            }
        } else {
            const int l = (w - 128) >> 4, r = (w - 128) & 15;
            g.A = (const bf16_t*)(ws + WS_MEMN); g.lda = DM; g.Bt = (const bf16_t*)(ws + WS_WT + (size_t)l * WT_LAYER + WT_MKV); g.ldb = DM; g.K = DM;
            S.pm = r >> 1; S.pn = r & 1; E.O = (bf16_t*)(ws + WS_KVM + (size_t)l * 2 * MiB); E.ldc = 512;
        }
        pg8::gemm_phase<EpiPlain, pg8::OneUnit>(c.lds, g, S, E, c.wave);
    }
}

template <int D>
__device__ __forceinline__ void wave_attn(const bf16_t* q, long qs, const bf16_t* k, const bf16_t* v, long ks, int t0, int t1, int tq, int W, float sc_l2,
                                          float& m, float& l, f32x16 (&O)[D / 32], LAS unsigned char* vbuf, int lane) {
    constexpr int NS = D / 16, ND = D / 32, VP = D * 2 + 16;
    const int r32 = lane & 31, hi = lane >> 5;
    bf16x8 qf[NS];
#pragma unroll
    for (int s = 0; s < NS; ++s) qf[s] = *(const GAS bf16x8*)(q + (long)r32 * qs + 16 * s + 8 * hi);
    constexpr int LPR = D / 8;
    constexpr int RPI = 64 / LPR;
    bf16x8 kf[NS]; u32x4 tmp[32 / RPI];
#define WA_LOAD(tt_) do { const bf16_t* kt = k + (long)(32 * (tt_) + r32) * ks + 8 * hi; \
        _Pragma("unroll") for (int s = 0; s < NS; ++s) kf[s] = *(const GAS bf16x8*)(kt + 16 * s); \
        const bf16_t* vt = v + (long)(32 * (tt_)) * ks; \
        _Pragma("unroll") for (int i = 0; i < 32 / RPI; ++i) { const int row = i * RPI + lane / LPR; tmp[i] = *(const GAS u32x4*)(vt + (long)row * ks + (lane % LPR) * 8); } } while (0)
    WA_LOAD(t0);
    for (int t = t0; t <= t1; ++t) {
        f32x16 S = {};
        __builtin_amdgcn_s_setprio(1);
#pragma unroll
        for (int s = 0; s < NS; ++s) S = __builtin_amdgcn_mfma_f32_32x32x16_bf16(kf[s], qf[s], S, 0, 0, 0);
        __builtin_amdgcn_s_setprio(0);
        asm volatile("" ::: "memory");
#pragma unroll
        for (int i = 0; i < 32 / RPI; ++i) { const int row = i * RPI + lane / LPR; *(LAS u32x4*)(vbuf + row * VP + (lane % LPR) * 16) = tmp[i]; }
        asm volatile("" ::: "memory");
        if (t < t1) { WA_LOAD(t + 1); }
        float mt = NEGBIG;
        if (W >= 0 && (t == t1 || 32 * (t - tq) - 31 < -W)) {
            const int db = 32 * (t - tq) - r32 + 4 * hi;
#pragma unroll
            for (int r = 0; r < 16; ++r) { const int dl = db + (r & 3) + 8 * (r >> 2); const bool ok = (dl <= 0) && (dl >= -W); S[r] = ok ? S[r] : NEGBIG; mt = fmaxf(mt, S[r]); }
        } else {
#pragma unroll
            for (int r = 0; r < 16; ++r) mt = fmaxf(mt, S[r]);
        }
        mt = xmax32(mt) * sc_l2;
        const float mn = fmaxf(m, mt);
        if (__any(mn > m + 8.0f)) {
            const float al = fexp2(m - mn); l *= al;
#pragma unroll
            for (int d = 0; d < ND; ++d)
#pragma unroll
                for (int r = 0; r < 16; ++r) O[d][r] *= al;
            m = mn;
        }
        float ps = 0.f;
#pragma unroll
        for (int r = 0; r < 16; ++r) { S[r] = fexp2(__builtin_fmaf(S[r], sc_l2, -m)); ps += S[r]; }
        l += ps;
        bf16x8 pf[2];
#pragma unroll
        for (int s2 = 0; s2 < 2; ++s2) { u32x4 w; w.x = cvt_pk_bf16(S[8 * s2 + 0], S[8 * s2 + 1]); w.y = cvt_pk_bf16(S[8 * s2 + 2], S[8 * s2 + 3]); w.z = cvt_pk_bf16(S[8 * s2 + 4], S[8 * s2 + 5]); w.w = cvt_pk_bf16(S[8 * s2 + 6], S[8 * s2 + 7]);
            pf[s2] = __builtin_bit_cast(bf16x8, w); }
        {
            const int blk = (lane >> 4) & 1, qq = (lane & 15) >> 2, pp = lane & 3;
            const LAS unsigned char* vb = vbuf + (4 * hi + qq) * VP + (16 * blk + 4 * pp) * 2;
            __builtin_amdgcn_s_setprio(1);
#pragma unroll
            for (int d = 0; d < ND; ++d)
#pragma unroll
                for (int s2 = 0; s2 < 2; ++s2) {
                    const s16x4 lo = __builtin_amdgcn_ds_read_tr16_b64_v4i16((LAS s16x4*)(vb + (16 * s2) * VP + d * 64));
                    const s16x4 hi4 = __builtin_amdgcn_ds_read_tr16_b64_v4i16((LAS s16x4*)(vb + (16 * s2 + 8) * VP + d * 64));
                    const bf16x8 vf = (bf16x8){lo[0], lo[1], lo[2], lo[3], hi4[0], hi4[1], hi4[2], hi4[3]};
                    O[d] = __builtin_amdgcn_mfma_f32_32x32x16_bf16(vf, pf[s2], O[d], 0, 0, 0);
                }
            __builtin_amdgcn_s_setprio(0);
        }
    }
}
#undef WA_LOAD
template <int D>
__device__ __forceinline__ void wave_attn2(const bf16_t* q, long qs, const bf16_t* k, const bf16_t* v, long ks, int t0, int t1, int tq, int W, float sc_l2,
                                           float (&m)[2], float (&l)[2], f32x16 (&O)[2][D / 32], LAS unsigned char* vbuf, int lane) {
    constexpr int NS = D / 16, ND = D / 32, VP = D * 2 + 16;
    const int r32 = lane & 31, hi = lane >> 5;
    bf16x8 qf[2][NS];
#pragma unroll
    for (int u = 0; u < 2; ++u)
#pragma unroll
        for (int s = 0; s < NS; ++s) qf[u][s] = *(const GAS bf16x8*)(q + (long)(32 * u + r32) * qs + 16 * s + 8 * hi);
    constexpr int LPR = D / 8, RPI = 64 / LPR;
    bf16x8 kf[NS]; u32x4 tmp[32 / RPI];
#define WA_LOAD(tt_) do { const bf16_t* kt = k + (long)(32 * (tt_) + r32) * ks + 8 * hi; \
        _Pragma("unroll") for (int s = 0; s < NS; ++s) kf[s] = *(const GAS bf16x8*)(kt + 16 * s); \
        const bf16_t* vt = v + (long)(32 * (tt_)) * ks; \
        _Pragma("unroll") for (int i = 0; i < 32 / RPI; ++i) { const int row = i * RPI + lane / LPR; tmp[i] = *(const GAS u32x4*)(vt + (long)row * ks + (lane % LPR) * 8); } } while (0)
    WA_LOAD(t0);
    for (int t = t0; t <= t1; ++t) {
        f32x16 S[2];
        bool act[2];
#pragma unroll
        for (int u = 0; u < 2; ++u) { act[u] = (W < 0) || (t <= tq + u && t >= tq + u - 4);
            S[u] = (f32x16){};
            if (act[u]) {
#pragma unroll
                for (int s = 0; s < NS; ++s) S[u] = __builtin_amdgcn_mfma_f32_32x32x16_bf16(kf[s], qf[u][s], S[u], 0, 0, 0); } }
        asm volatile("" ::: "memory");
#pragma unroll
        for (int i = 0; i < 32 / RPI; ++i) { const int row = i * RPI + lane / LPR; *(LAS u32x4*)(vbuf + row * VP + (lane % LPR) * 16) = tmp[i]; }
        asm volatile("" ::: "memory");
        if (t < t1) { WA_LOAD(t + 1); }
        bf16x8 pf[2][2];
#pragma unroll
        for (int u = 0; u < 2; ++u) {
            if (act[u]) {
                float mt = NEGBIG; const int tqu = tq + u;
                if (W >= 0 && (t == tqu || 32 * (t - tqu) - 31 < -W)) {
                    const int db = 32 * (t - tqu) - r32 + 4 * hi;
#pragma unroll
                    for (int r = 0; r < 16; ++r) { const int dl = db + (r & 3) + 8 * (r >> 2); const bool ok = (dl <= 0) && (dl >= -W); S[u][r] = ok ? S[u][r] : NEGBIG; mt = fmaxf(mt, S[u][r]); }
                } else {
#pragma unroll
                    for (int r = 0; r < 16; ++r) mt = fmaxf(mt, S[u][r]);
                }
                mt = xmax32(mt) * sc_l2;
                const float mn = fmaxf(m[u], mt);
                if (__any(mn > m[u] + 8.0f)) {
                    const float al = fexp2(m[u] - mn); l[u] *= al;
#pragma unroll
                    for (int d = 0; d < ND; ++d)
#pragma unroll
                        for (int r = 0; r < 16; ++r) O[u][d][r] *= al;
                    m[u] = mn;
                }
                float ps = 0.f;
#pragma unroll
                for (int r = 0; r < 16; ++r) { S[u][r] = fexp2(__builtin_fmaf(S[u][r], sc_l2, -m[u])); ps += S[u][r]; }
                l[u] += ps;
#pragma unroll
                for (int s2 = 0; s2 < 2; ++s2) { u32x4 w; w.x = cvt_pk_bf16(S[u][8 * s2 + 0], S[u][8 * s2 + 1]); w.y = cvt_pk_bf16(S[u][8 * s2 + 2], S[u][8 * s2 + 3]); w.z = cvt_pk_bf16(S[u][8 * s2 + 4], S[u][8 * s2 + 5]); w.w = cvt_pk_bf16(S[u][8 * s2 + 6], S[u][8 * s2 + 7]);
                    pf[u][s2] = __builtin_bit_cast(bf16x8, w); }
            } else { pf[u][0] = (bf16x8){0, 0, 0, 0, 0, 0, 0, 0}; pf[u][1] = (bf16x8){0, 0, 0, 0, 0, 0, 0, 0}; }
        }
        {
            const int blk = (lane >> 4) & 1, qq = (lane & 15) >> 2, pp = lane & 3;
            const LAS unsigned char* vb = vbuf + (4 * hi + qq) * VP + (16 * blk + 4 * pp) * 2;
            __builtin_amdgcn_s_setprio(1);
#pragma unroll
            for (int d = 0; d < ND; ++d)
#pragma unroll
                for (int s2 = 0; s2 < 2; ++s2) {
                    const s16x4 lo = __builtin_amdgcn_ds_read_tr16_b64_v4i16((LAS s16x4*)(vb + (16 * s2) * VP + d * 64));
                    const s16x4 hi4 = __builtin_amdgcn_ds_read_tr16_b64_v4i16((LAS s16x4*)(vb + (16 * s2 + 8) * VP + d * 64));
                    const bf16x8 vf = (bf16x8){lo[0], lo[1], lo[2], lo[3], hi4[0], hi4[1], hi4[2], hi4[3]};
                    O[0][d] = __builtin_amdgcn_mfma_f32_32x32x16_bf16(vf, pf[0][s2], O[0][d], 0, 0, 0);
                    O[1][d] = __builtin_amdgcn_mfma_f32_32x32x16_bf16(vf, pf[1][s2], O[1][d], 0, 0, 0);
                }
            __builtin_amdgcn_s_setprio(0);
        }
    }
#undef WA_LOAD
}
template <int D>
__device__ __forceinline__ void store_ot(const f32x16 (&O)[D / 32], float inv_l, bf16_t* out, long os, int lane) {
    const int r32 = lane & 31, hi = lane >> 5;
#pragma unroll
    for (int d = 0; d < D / 32; ++d)
#pragma unroll
        for (int g = 0; g < 4; ++g) { u32x2 w; w.x = cvt_pk_bf16(O[d][4 * g] * inv_l, O[d][4 * g + 1] * inv_l); w.y = cvt_pk_bf16(O[d][4 * g + 2] * inv_l, O[d][4 * g + 3] * inv_l);
            *(GAS u32x2*)(out + (long)r32 * os + 32 * d + 8 * g + 4 * hi) = w; }
}

template <int D>
__device__ __forceinline__ void stage_ot(const f32x16 (&O)[D / 32], float sc, LAS unsigned char* stg, int lane) {
    constexpr int VP = D * 2 + 16; const int r32 = lane & 31, hi = lane >> 5;
    asm volatile("" ::: "memory");
#pragma unroll
    for (int d = 0; d < D / 32; ++d)
#pragma unroll
        for (int g = 0; g < 4; ++g) { u32x2 w; w.x = cvt_pk_bf16(O[d][4 * g] * sc, O[d][4 * g + 1] * sc); w.y = cvt_pk_bf16(O[d][4 * g + 2] * sc, O[d][4 * g + 3] * sc);
            *(LAS u32x2*)(stg + r32 * VP + (32 * d + 8 * g + 4 * hi) * 2) = w; }
    asm volatile("" ::: "memory");
}
template <int D>
__device__ __forceinline__ void store_staged(const LAS unsigned char* stg, bf16_t* out, long os, int lane) {
    constexpr int VP = D * 2 + 16, LPR = D / 8, RPI = 64 / LPR;
#pragma unroll
    for (int i = 0; i < 32 / RPI; ++i) { const int row = i * RPI + lane / LPR; const u32x4 v = *(const LAS u32x4*)(stg + row * VP + (lane % LPR) * 16); *(GAS u32x4*)(out + (long)row * os + (lane % LPR) * 8) = v; }
    asm volatile("" ::: "memory");
}

__device__ __forceinline__ void mem_attn_units(const Ctx& c0, bf16_t* Obase, int ldo, int coloff, const bf16_t* kvm) {
    const Ctx c = launder(c0);
    LAS unsigned char* vbuf = c.lds + c.wave * 8704;
    for (int u = c.gw; u < 2048; u += c.NGW) {
        const int qt = u & 63, h = (u >> 6) & 3, b = u >> 8;
        bf16_t* q = Obase + (size_t)(b * SEQ + 64 * qt) * ldo + coloff + h * 64;
        const bf16_t* k = kvm + (size_t)(b * MEMLEN) * 512 + h * 64;
        float m[2] = {NEGBIG, NEGBIG}, l[2] = {0.f, 0.f}; f32x16 O[2][2] = {};
        wave_attn2<64>(q, ldo, k, k + 256, 512, 0, 7, 0, -1, 0.125f * LOG2E, m, l, O, vbuf, c.lane);
#pragma unroll
        for (int s = 0; s < 2; ++s) { const float ls = xsum32(l[s]);
            stage_ot<64>(O[s], 1.0f / ls, vbuf, c.lane); store_staged<64>(vbuf, q + (size_t)(32 * s) * ldo, ldo, c.lane); }
    }
}

__device__ __forceinline__ void swa_units(const Ctx& c0, unsigned char* ws, const float* sinks) {
    const Ctx c = launder(c0);
    LAS unsigned char* vbuf = c.lds + c.wave * 8704;
    bf16_t* OB = (bf16_t*)(ws + WS_OB); const bf16_t* KB = (const bf16_t*)(ws + WS_KB); const bf16_t* VB = (const bf16_t*)(ws + WS_VB);
    for (int u = c.gw; u < 8192; u += c.NGW) {
        const int qt2 = u & 63, h = (u >> 6) & 15, b = u >> 10, kvh = h >> 2, qt = 2 * qt2;
        bf16_t* q = OB + (size_t)(b * SEQ + 32 * qt) * LDOB + h * 64;
        const bf16_t* k = KB + (size_t)(b * SEQ) * 256 + kvh * 64; const bf16_t* v = VB + (size_t)(b * SEQ) * 256 + kvh * 64;
        const float sk = ((const GAS float*)sinks)[h] * LOG2E, l0 = (c.lane < 32) ? 1.f : 0.f;
        float m[2] = {sk, sk}, l[2] = {l0, l0}; f32x16 O[2][2] = {};
        const int t0 = qt - 4 < 0 ? 0 : qt - 4;
        wave_attn2<64>(q, LDOB, k, v, 256, t0, qt + 1, qt, 127, 0.125f * LOG2E, m, l, O, vbuf, c.lane);
#pragma unroll
        for (int s = 0; s < 2; ++s) { const float ls = xsum32(l[s]);
            stage_ot<64>(O[s], 1.0f / ls, vbuf, c.lane); store_staged<64>(vbuf, q + (size_t)(32 * s) * LDOB, LDOB, c.lane); }
    }
}

__device__ __forceinline__ void dil_units(const Ctx& c0, unsigned char* ws, bf16_t* p1buf, int br_lo, int br_hi) {
    const Ctx c = launder(c0);
    LAS unsigned char* vbuf = c.lds + c.wave * 8704;
    bf16_t* OC = (bf16_t*)(ws + WS_OC); const bf16_t* KC = (const bf16_t*)(ws + WS_KC); const bf16_t* VC = (const bf16_t*)(ws + WS_VC);
    GAS float* LSE = (GAS float*)(ws + WS_LSE);
    const int nun = (br_hi - br_lo) * 8192;
    const float sc = 0.08838834764831845f * LOG2E;
    for (int uu = c.gw; uu < nun; uu += c.NGW) {
        const int br = br_lo + (uu >> 13), u = uu & 8191;
        const int dsh = 2 * br, d = 1 << dsh, tps = 128 >> dsh;
        const int bh = u >> 7, b = bh >> 3, h = bh & 7, rho = (u & 127) / tps, tq = (u & 127) % tps;
        const size_t tok0 = (size_t)b * SEQ + rho;
        bf16_t* q = OC + (tok0 + (size_t)d * 32 * tq) * LDOB + h * 128;
        const bf16_t* k = KC + tok0 * 1024 + h * 128; const bf16_t* v = VC + tok0 * 1024 + h * 128;
        float m = NEGBIG, l = 0.f; f32x16 O[4] = {};
        const int t0 = tq - 4 < 0 ? 0 : tq - 4;
        float l0 = 0.f, l1 = 0.f;
        if (br == 2) { const size_t tk = tok0 + (size_t)d * (32 * tq + (c.lane & 31)); l0 = LSE[tk * 8 + h]; l1 = LSE[(size_t)MTOK * 8 + tk * 8 + h]; }
        wave_attn<128>(q, (long)d * LDOB, k, v, (long)d * 1024, t0, tq, tq, 128, sc, m, l, O, vbuf, c.lane);
        l = xsum32(l);
        const float inv_l = 1.0f / l, lse = m + __log2f(l);
        int tq_ = tq, rho_ = rho; asm volatile("" : "+s"(tq_), "+s"(rho_));
        const int ln = lane_id(), r32 = ln & 31, hi = ln >> 5;
        const size_t tok0b = (size_t)b * SEQ + rho_;
        const size_t tok = tok0b + (size_t)d * (32 * tq_ + r32);
        if (br < 2) {
            bf16_t* P = (br == 0) ? p1buf : (bf16_t*)(ws + WS_P2);
            stage_ot<128>(O, inv_l, vbuf, ln); store_staged<128>(vbuf, P + (tok0b + (size_t)d * 32 * tq_) * 1024 + h * 128, (long)d * 1024, ln);
            if (hi == 0) LSE[(size_t)br * MTOK * 8 + tok * 8 + h] = lse;
        } else {
            const float mx = fmaxf(fmaxf(l0, l1), lse);
            float w0 = fexp2(l0 - mx), w1 = fexp2(l1 - mx), w2 = fexp2(lse - mx); const float ws_ = 1.0f / (w0 + w1 + w2); w0 *= ws_; w1 *= ws_; w2 *= ws_ * inv_l;
            stage_ot<128>(O, w2, vbuf, ln);
            if (hi == 0) *(LAS f32x2*)(vbuf + r32 * 272 + 256) = (f32x2){w0, w1};
            asm volatile("" ::: "memory");
            const size_t tokq0 = tok0b + (size_t)d * 32 * tq_;
            u32x4 a1[8], a2[8];
#pragma unroll
            for (int i = 0; i < 8; ++i) { const int row = i * 4 + (ln >> 4), chv = ln & 15; const size_t tr = tokq0 + (size_t)d * row;
                a1[i] = *(const GAS u32x4*)((const bf16_t*)p1buf + tr * 1024 + h * 128 + chv * 8); a2[i] = *(const GAS u32x4*)((const bf16_t*)(ws + WS_P2) + tr * 1024 + h * 128 + chv * 8); }
            __builtin_amdgcn_sched_barrier(0);
#pragma unroll
            for (int i = 0; i < 8; ++i) { const int row = i * 4 + (ln >> 4), chv = ln & 15; const size_t tr = tokq0 + (size_t)d * row;
                const u32x4 a3 = *(const LAS u32x4*)(vbuf + row * 272 + chv * 16); const f32x2 ww = *(const LAS f32x2*)(vbuf + row * 272 + 256);
                u32x4 w;
#pragma unroll
                for (int e = 0; e < 4; ++e) w[e] = cvt_pk_bf16(ww.x * bflo(a1[i][e]) + ww.y * bflo(a2[i][e]) + bflo(a3[e]), ww.x * bfhi(a1[i][e]) + ww.y * bfhi(a2[i][e]) + bfhi(a3[e]));
                *(GAS u32x4*)(OC + tr * LDOB + h * 128 + chv * 8) = w; }
            asm volatile("" ::: "memory");
        }
    }
}

__device__ __forceinline__ void ckv_norm_rows(const Ctx& c0, unsigned char* ws, const float* gain) {
    const Ctx c = launder(c0);
    bf16_t* CKV = (bf16_t*)(ws + WS_CKV);
    const f32x4 g = *((const f32x4*)gain + c.lane);
    for (int m0 = c.gw; m0 < MTOK; m0 += 4 * c.NGW) {
        u32x2 w[4];
#pragma unroll
        for (int j = 0; j < 4; ++j) { const int m = m0 + j * c.NGW; w[j] = *((const GAS u32x2*)(CKV + (size_t)(m < MTOK ? m : MTOK - 1) * CKVP) + c.lane); }
#pragma unroll
        for (int j = 0; j < 4; ++j) { const int m = m0 + j * c.NGW;
            const float v0 = bflo(w[j].x), v1 = bfhi(w[j].x), v2 = bflo(w[j].y), v3 = bfhi(w[j].y);
            const float rstd = __builtin_amdgcn_rsqf(wave_sum(v0 * v0 + v1 * v1 + v2 * v2 + v3 * v3) * (1.f / 256.f) + EPS);
            u32x2 o; o.x = cvt_pk_bf16(v0 * rstd * g.x, v1 * rstd * g.y); o.y = cvt_pk_bf16(v2 * rstd * g.z, v3 * rstd * g.w);
            if (m < MTOK) *((GAS u32x2*)(CKV + (size_t)m * CKVP) + c.lane) = o; }
    }
}
__device__ __forceinline__ void hist_select(const LAS unsigned* hist, int K, int lane, int& bin, int& above, int& inbin) {
    const u32x4 hc = *(const LAS u32x4*)(hist + 4 * lane);
    const int tot = (int)(hc.x + hc.y + hc.z + hc.w);
    int pre = tot;
#define HS_DPP(v_, ctl_, rm_) __builtin_amdgcn_update_dpp(0, (v_), (ctl_), (rm_), 0xf, true)
    pre += HS_DPP(pre, 0x111, 0xf); pre += HS_DPP(pre, 0x112, 0xf); pre += HS_DPP(pre, 0x114, 0xf); pre += HS_DPP(pre, 0x118, 0xf);
    pre += HS_DPP(pre, 0x142, 0xa);
    pre += HS_DPP(pre, 0x143, 0xc);
#undef HS_DPP
    const int all = __builtin_amdgcn_readlane(pre, 63);
    const int suf = all - pre + tot;
    const unsigned long long bal = __ballot(suf >= K);
    const int L = __builtin_amdgcn_readfirstlane(63 - __builtin_clzll(bal | 1ull));
    const int sufL = __builtin_amdgcn_readlane(suf, L), totL = __builtin_amdgcn_readlane(tot, L);
    const int c3 = __builtin_amdgcn_readlane((int)hc.w, L), c2 = __builtin_amdgcn_readlane((int)hc.z, L), c1 = __builtin_amdgcn_readlane((int)hc.y, L), c0 = __builtin_amdgcn_readlane((int)hc.x, L);
    int ab = sufL - totL;
    if (ab + c3 >= K) { bin = 4 * L + 3; above = ab; inbin = c3; return; } ab += c3;
    if (ab + c2 >= K) { bin = 4 * L + 2; above = ab; inbin = c2; return; } ab += c2;
    if (ab + c1 >= K) { bin = 4 * L + 1; above = ab; inbin = c1; return; } ab += c1;
    bin = 4 * L; above = ab; inbin = c0;
}
__device__ __forceinline__ int f2ord(float f) { const int b = __builtin_bit_cast(int, f); return b >= 0 ? b : (b ^ 0x7fffffff); }
__device__ __forceinline__ float ord2f(int o) { return __builtin_bit_cast(float, o >= 0 ? o : (o ^ 0x7fffffff)); }
constexpr int IX_CMAX = 128;
#define IX_KEY(v_) ({ int k_ = (int)(((v_) - mn) * scale); k_ > 65535 ? 65535 : (k_ < 0 ? 0 : k_); })
__device__ __forceinline__ void select_token(const LAS float* row, LAS unsigned* hist, LAS unsigned* cand, int n, float mn, float mx, unsigned short* out_, int lane) {
    GAS unsigned short* out = (GAS unsigned short*)out_;
    if (n <= 256) {
#pragma unroll
        for (int i = 0; i < 4; ++i) { const int j = lane + 64 * i; out[j] = (unsigned short)(j < n ? j : 0); }
        return;
    }
    const float scale = (mx > mn) ? 65535.0f / (mx - mn) : 0.f;
    LAS unsigned short* stg = (LAS unsigned short*)hist;
#define IX_FLUSH() do { asm volatile("" ::: "memory"); const u32x2 fv_ = *(const LAS u32x2*)(hist + 2 * lane); *(GAS u32x2*)(out + 4 * lane) = fv_; asm volatile("" ::: "memory"); } while (0)
    { unsigned z = 0u; asm volatile("" : "+v"(z)); *(LAS u32x4*)(hist + 4 * lane) = (u32x4){z, z, z, z}; }
    for (int j0 = lane; j0 < n; j0 += 512) {
        float v[8];
#pragma unroll
        for (int k = 0; k < 8; ++k) { const int j = j0 + 64 * k; v[k] = (j < n) ? row[j] : mn; }
#pragma unroll
        for (int k = 0; k < 8; ++k) { const int j = j0 + 64 * k; const int key = IX_KEY(v[k]);
            if (j < n) __hip_atomic_fetch_add(hist + (key >> 8), 1u, __ATOMIC_RELAXED, __HIP_MEMORY_SCOPE_WORKGROUP); }
    }
    int b1, ab1, in1; hist_select(hist, 256, lane, b1, ab1, in1);
    const int K2 = 256 - ab1;
    if (in1 <= IX_CMAX) {
        int base = 0, cb = 0;
        for (int j0 = lane; j0 < n; j0 += 512) {
            float v[8];
#pragma unroll
            for (int k = 0; k < 8; ++k) { const int j = j0 + 64 * k; v[k] = (j < n) ? row[j] : mn; }
#pragma unroll
            for (int k = 0; k < 8; ++k) {
                const int j = j0 + 64 * k; const int key = IX_KEY(v[k]); const int bin = (j < n) ? (key >> 8) : -1;
                const bool gt = bin > b1, eq = bin == b1;
                const unsigned long long bg = __ballot(gt), be = __ballot(eq);
                const int pg = base + (int)__builtin_amdgcn_mbcnt_hi((unsigned)(bg >> 32), __builtin_amdgcn_mbcnt_lo((unsigned)bg, 0u));
                const int pe = cb + (int)__builtin_amdgcn_mbcnt_hi((unsigned)(be >> 32), __builtin_amdgcn_mbcnt_lo((unsigned)be, 0u));
                if (gt && pg < 256) stg[pg] = (unsigned short)j;
                if (eq && pe < IX_CMAX) cand[pe] = ((unsigned)(key & 255) << 16) | (unsigned)(0xFFFF - j);
                base += __builtin_popcountll(bg); cb += __builtin_popcountll(be);
            }
        }
#pragma unroll
        for (int h = 0; h < IX_CMAX / 64; ++h) { const int i = lane + 64 * h;
            if (i < in1) { const unsigned me = cand[i]; int rank = 0; for (int c2 = 0; c2 < in1; ++c2) rank += (cand[c2] > me) ? 1 : 0;
                if (rank < K2) stg[ab1 + rank] = (unsigned short)(0xFFFF - (me & 0xFFFFu)); } }
        IX_FLUSH();
        return;
    }
    { unsigned z = 0u; asm volatile("" : "+v"(z)); *(LAS u32x4*)(hist + 4 * lane) = (u32x4){z, z, z, z}; }
    for (int j0 = lane; j0 < n; j0 += 64) { const int key = IX_KEY(row[j0]); if ((key >> 8) == b1) __hip_atomic_fetch_add(hist + (key & 255), 1u, __ATOMIC_RELAXED, __HIP_MEMORY_SCOPE_WORKGROUP); }
    int b2, ab2, in2; hist_select(hist, K2, lane, b2, ab2, in2);
    const int T = (b1 << 8) | b2, krem = K2 - ab2;
    int base = 0, eqb = 0;
    for (int j0 = 0; j0 < n; j0 += 64) {
        const int j = j0 + lane; const int key = (j < n) ? IX_KEY(row[j]) : -1;
        const bool gt = key > T, eq = key == T;
        const unsigned long long beq = __ballot(eq);
        const int rk = eqb + (int)__builtin_amdgcn_mbcnt_hi((unsigned)(beq >> 32), __builtin_amdgcn_mbcnt_lo((unsigned)beq, 0u));
        const bool sel = gt || (eq && rk < krem);
        const unsigned long long bs = __ballot(sel);
        const int pos = base + (int)__builtin_amdgcn_mbcnt_hi((unsigned)(bs >> 32), __builtin_amdgcn_mbcnt_lo((unsigned)bs, 0u));
        if (sel && pos < 256) stg[pos] = (unsigned short)j;
        base += __builtin_popcountll(bs); eqb += __builtin_popcountll(beq);
    }
    IX_FLUSH();
}
#undef IX_FLUSH
#undef IX_KEY
constexpr int IDX_ROWW = 4224;
__device__ __forceinline__ void indexer_load_q(bf16x8 (&af)[4][4], const bf16_t* QI, size_t tokb, int t0) {
    const int lane = lane_id(), r32 = lane & 31, hi = lane >> 5, tk = (r32 >> 2) & 1, hd = (r32 & 3) + 4 * (r32 >> 3);
#pragma unroll
    for (int p = 0; p < 4; ++p) { const bf16_t* qrow = QI + (tokb + t0 + 2 * p + tk) * 1024 + hd * 64 + 8 * hi;
#pragma unroll
        for (int s = 0; s < 4; ++s) af[p][s] = *(const GAS bf16x8*)(qrow + 16 * s); }
}
__device__ __forceinline__ void indexer_scores(const bf16x8 (&af)[4][4], const bf16_t* KI, const float* WI, size_t tokb, int t0, int ntile, int rot, LAS float* sc, int coff, float (&lo_out)[4], float (&hi_out)[4], LAS f32x4* WVL, int w) {
    const int lane = lane_id();
    const int r32 = lane & 31, hi = lane >> 5;
    float lo4[4], hi4[4];
#pragma unroll
    for (int p = 0; p < 4; ++p) { lo4[p] = 3.0e38f; hi4[p] = -3.0e38f; }
    const f32x4 wv_ = *((const GAS f32x4*)(WI + (tokb + t0 + ((lane & 31) >> 2)) * 16) + (lane & 3));
    bf16x8 k0[4], k1[4], k2[4];
#define IXS_LOAD(dst_, tile_) do { const bf16_t* krow = KI + (tokb + 32 * (tile_) + r32) * 64 + 8 * hi; _Pragma("unroll") for (int s = 0; s < 4; ++s) dst_[s] = *(const GAS bf16x8*)(krow + 16 * s); } while (0)
#define IXS_COMP(kf_, tile_) do { f32x16 acc0 = {}, acc1 = {}, acc2 = {}, acc3 = {};                    \
        _Pragma("unroll") for (int s = 0; s < 4; ++s) { acc0 = __builtin_amdgcn_mfma_f32_32x32x16_bf16(af[0][s], kf_[s], acc0, 0, 0, 0); acc1 = __builtin_amdgcn_mfma_f32_32x32x16_bf16(af[1][s], kf_[s], acc1, 0, 0, 0); \
            acc2 = __builtin_amdgcn_mfma_f32_32x32x16_bf16(af[2][s], kf_[s], acc2, 0, 0, 0); acc3 = __builtin_amdgcn_mfma_f32_32x32x16_bf16(af[3][s], kf_[s], acc3, 0, 0, 0); } \
        IXS_RED(0, acc0, tile_); IXS_RED(1, acc1, tile_); IXS_RED(2, acc2, tile_); IXS_RED(3, acc3, tile_); } while (0)
#define IXS_RED(p, acc, tile_) do { float s0 = 0.f, s1 = 0.f; \
            _Pragma("unroll") for (int r4 = 0; r4 < 4; ++r4) { const f32x4 wq = WVL[(2 * (p) + hi) * 4 + r4]; \
                s0 += wq[0] * __builtin_amdgcn_fmed3f(acc[4 * r4], 0.f, 3.0e38f); s1 += wq[1] * __builtin_amdgcn_fmed3f(acc[4 * r4 + 1], 0.f, 3.0e38f); s0 += wq[2] * __builtin_amdgcn_fmed3f(acc[4 * r4 + 2], 0.f, 3.0e38f); s1 += wq[3] * __builtin_amdgcn_fmed3f(acc[4 * r4 + 3], 0.f, 3.0e38f); } \
            const float sv = s0 + s1; sc[(2 * (p) + hi) * IDX_ROWW + coff + 32 * (tile_) + r32] = sv; lo4[p] = fminf(lo4[p], sv); hi4[p] = fmaxf(hi4[p], sv); } while (0)
    int tile = (w - rot) & 7;
    const int tlast = ntile - 1;
#define IXS_CL(t_) ((t_) < tlast ? (t_) : tlast)
    IXS_LOAD(k0, IXS_CL(tile)); IXS_LOAD(k1, IXS_CL(tile + 8)); IXS_LOAD(k2, IXS_CL(tile + 16));
    if (lane < 32) WVL[lane] = wv_;
    for (; tile < ntile; tile += 24) {
        IXS_COMP(k0, tile); IXS_LOAD(k0, IXS_CL(tile + 24));
        if (tile + 8 < ntile) IXS_COMP(k1, tile + 8);
        IXS_LOAD(k1, IXS_CL(tile + 32));
        if (tile + 16 < ntile) IXS_COMP(k2, tile + 16);
        IXS_LOAD(k2, IXS_CL(tile + 40));
    }
#undef IXS_CL
#undef IXS_LOAD
#undef IXS_COMP
#undef IXS_RED
#pragma unroll
    for (int p = 0; p < 4; ++p) { lo_out[p] = lo4[p]; hi_out[p] = hi4[p]; }
}
__device__ __forceinline__ void indexer_minmax(const float (&lo4)[4], const float (&hi4)[4], LAS int* mm) {
    const int lane = lane_id(), r32 = lane & 31, hi = lane >> 5;
#pragma unroll
    for (int p = 0; p < 4; ++p) { const float lo = half_min(lo4[p]), hx = half_max(hi4[p]);
        if (r32 == 0) { __hip_atomic_fetch_min(mm + 2 * (2 * p + hi), f2ord(lo), __ATOMIC_RELAXED, __HIP_MEMORY_SCOPE_WORKGROUP);
                        __hip_atomic_fetch_max(mm + 2 * (2 * p + hi) + 1, f2ord(hx), __ATOMIC_RELAXED, __HIP_MEMORY_SCOPE_WORKGROUP); } }
}
__device__ __forceinline__ void indexer_phase(const Ctx& c0, unsigned char* ws) {
    const Ctx c = launder(c0);
    const bf16_t* QI = (const bf16_t*)(ws + WS_QI); const bf16_t* KI = (const bf16_t*)(ws + WS_KI); const float* WI = (const float*)(ws + WS_WI);
    unsigned short* IDX = (unsigned short*)(ws + WS_IDX);
    LAS float* sc = (LAS float*)c.lds;
    LAS unsigned* hist = (LAS unsigned*)(c.lds + 8 * IDX_ROWW * 4) + c.wave * 256;
    LAS int* mm = (LAS int*)(c.lds + 8 * IDX_ROWW * 4 + 8 * 1024);
    LAS f32x4* WVL = (LAS f32x4*)(c.lds + 8 * IDX_ROWW * 4 + 8 * 1024 + 256 + c.wave * 512);
    LAS unsigned* cand = (LAS unsigned*)(c.lds + 8 * IDX_ROWW * 4 + 8 * 1024 + 256 + 4096 + c.wave * (IX_CMAX * 4));
    const int lane = c.lane, w = c.wave;
    if (c.tid < 32) mm[c.tid] = (c.tid & 1) ? (int)0x80000001 : 0x7fffffff;
    __syncthreads();
    bf16x8 afA[4][4];
    { const int P0 = c.vcu < 2048 ? c.vcu : 0; indexer_load_q(afA, QI, (size_t)(P0 >> 8) * SEQ, 8 * (P0 & 255)); }
    for (int P = c.vcu; P < 2048; P += c.G) {
        const int b = P >> 8, up = P & 255;
        const int tA = 8 * up, tB = 8 * (511 - up), ntA = (tA + 8 + 31) >> 5, ntB = (tB + 8 + 31) >> 5, offB = 32 * ntA;
        const size_t tokb = (size_t)b * SEQ;
        float loA[4], hiA[4], loB[4], hiB[4];
        indexer_scores(afA, KI, WI, tokb, tA, ntA, 0, sc, 0, loA, hiA, WVL, w);
        { bf16x8 afB[4][4]; indexer_load_q(afB, QI, tokb, tB);
          indexer_minmax(loA, hiA, mm);
          indexer_scores(afB, KI, WI, tokb, tB, ntB, ntA & 7, sc, offB, loB, hiB, WVL, w); }
        { const int Pn = (P + c.G < 2048) ? P + c.G : P; indexer_load_q(afA, QI, (size_t)(Pn >> 8) * SEQ, 8 * (Pn & 255)); }
        indexer_minmax(loB, hiB, mm + 16);
        __syncthreads();
        const float mnA = ord2f(mm[2 * w]), mxA = ord2f(mm[2 * w + 1]), mnB = ord2f(mm[16 + 2 * w]), mxB = ord2f(mm[16 + 2 * w + 1]);
        select_token(sc + w * IDX_ROWW, hist, cand, tA + w + 1, mnA, mxA, IDX + (tokb + tA + w) * 256, lane);
        select_token(sc + w * IDX_ROWW + offB, hist, cand, tB + w + 1, mnB, mxB, IDX + (tokb + tB + w) * 256, lane);
        __syncthreads();
        if (c.tid < 32) mm[c.tid] = (c.tid & 1) ? (int)0x80000001 : 0x7fffffff;
        __syncthreads();
    }
}

__device__ __forceinline__ void sparse_attn_phase(const Ctx& c0, unsigned char* ws) {
    const Ctx c = launder(c0);
    constexpr int RP = 592;
    bf16_t* OA = (bf16_t*)(ws + WS_OA); const bf16_t* QR = (const bf16_t*)(ws + WS_QR); const bf16_t* CKV = (const bf16_t*)(ws + WS_CKV);
    const unsigned short* IDX = (const unsigned short*)(ws + WS_IDX);
    LAS unsigned char* buf = c.lds + c.wave * (32 * RP);
    const int lane = c.lane, hd = lane & 15, g = lane >> 4, hi = lane >> 5;
    const float sc = 0.08838834764831845f * LOG2E;
    int id0n = (c.gw < MTOK) ? (int)((const GAS unsigned short*)IDX)[(size_t)c.gw * 256 + (lane & 31)] : 0;
    for (int tok = c.gw; tok < MTOK; tok += c.NGW) {
        const int b = tok >> 12, t = tok & 4095, nsel = t + 1 < 256 ? t + 1 : 256, nch = (nsel + 31) >> 5;
        bf16x8 qf[9];
        { int ln = lane_id(); asm volatile("" : "+v"(ln)); const int hq = ln & 15, gq = ln >> 4;
#pragma unroll
          for (int s = 0; s < 8; ++s) qf[s] = (hq < 8) ? *(const GAS bf16x8*)(OA + (size_t)tok * LDOA + hq * 256 + 32 * s + 8 * gq) : (bf16x8){0, 0, 0, 0, 0, 0, 0, 0};
          qf[8] = (hq < 8) ? *(const GAS bf16x8*)(QR + (size_t)tok * 256 + hq * 32 + 8 * gq) : (bf16x8){0, 0, 0, 0, 0, 0, 0, 0}; }
        float m = NEGBIG, l = 0.f; f32x4 O[16];
#pragma unroll
        for (int d = 0; d < 16; ++d) O[d] = (f32x4){0.f, 0.f, 0.f, 0.f};
        const bf16_t* ckb = CKV + (size_t)b * SEQ * CKVP;
#define SA_GATHER(id_) do { const GAS unsigned char* cb_ = (const GAS unsigned char*)ckb;                  \
        _Pragma("unroll") for (int i = 0; i < 16; ++i) { const unsigned ra = (unsigned)__builtin_amdgcn_readlane((id_), 2 * i), rb = (unsigned)__builtin_amdgcn_readlane((id_), 2 * i + 1); const unsigned r = hi ? rb : ra; \
            unsigned of_ = __umul24(r, 576u) + lo16_; asm volatile("" : "+v"(of_)); tmp[i] = *(const GAS u32x4*)(cb_ + of_); } \
        _Pragma("unroll") for (int i = 0; i < 2; ++i) { const unsigned r = (unsigned)__shfl((id_), 16 * i + (lane >> 2)); unsigned of_ = __umul24(r, 576u) + 512u + t16_; asm volatile("" : "+v"(of_)); tmp[16 + i] = *(const GAS u32x4*)(cb_ + of_); } } while (0)
        const unsigned lo16_ = (unsigned)(lane & 31) * 16u, t16_ = (unsigned)(lane & 3) * 16u;
        u32x4 tmp[18];
        const GAS unsigned short* idp = (const GAS unsigned short*)(IDX + (size_t)tok * 256 + (lane & 31));
        { const int id0 = id0n; SA_GATHER(id0); }
        { const int tn = tok + c.NGW < MTOK ? tok + c.NGW : tok; id0n = (int)((const GAS unsigned short*)IDX)[(size_t)tn * 256 + (lane & 31)]; }
        int nid = (int)idp[nch > 1 ? 32 : 0];
        for (int ch = 0; ch < nch; ++ch) {
            asm volatile("" ::: "memory");
#pragma unroll
            for (int i = 0; i < 16; ++i) *(LAS u32x4*)(buf + (2 * i + hi) * RP + (lane & 31) * 16) = tmp[i];
#pragma unroll
            for (int i = 0; i < 2; ++i) *(LAS u32x4*)(buf + (16 * i + (lane >> 2)) * RP + 512 + (lane & 3) * 16) = tmp[16 + i];
            asm volatile("" ::: "memory");
            { const int nid2 = (int)idp[32 * ((ch + 2 < nch) ? ch + 2 : nch - 1)]; if (ch + 1 < nch) { SA_GATHER(nid); } nid = nid2; }
            __builtin_amdgcn_s_setprio(1);
            f32x4 S0 = {0.f, 0.f, 0.f, 0.f}, S1 = {0.f, 0.f, 0.f, 0.f};
#pragma unroll
            for (int s = 0; s < 9; ++s) {
                const bf16x8 a0 = *(const LAS bf16x8*)(buf + hd * RP + (32 * s + 8 * g) * 2);
                const bf16x8 a1 = *(const LAS bf16x8*)(buf + (16 + hd) * RP + (32 * s + 8 * g) * 2);
                S0 = __builtin_amdgcn_mfma_f32_16x16x32_bf16(a0, qf[s], S0, 0, 0, 0);
                S1 = __builtin_amdgcn_mfma_f32_16x16x32_bf16(a1, qf[s], S1, 0, 0, 0);
            }
            __builtin_amdgcn_sched_group_barrier(0x100, 4, 0);
#pragma unroll
            for (int i = 0; i < 7; ++i) { __builtin_amdgcn_sched_group_barrier(0x008, 2, 0); __builtin_amdgcn_sched_group_barrier(0x100, 2, 0); }
            __builtin_amdgcn_sched_group_barrier(0x008, 4, 0);
            __builtin_amdgcn_s_setprio(0);
            float mt = NEGBIG;
            const int kb = 32 * ch + 4 * g;
#pragma unroll
            for (int r = 0; r < 4; ++r) { S0[r] = (kb + r < nsel) ? S0[r] : NEGBIG; S1[r] = (kb + 16 + r < nsel) ? S1[r] : NEGBIG; mt = fmaxf(mt, fmaxf(S0[r], S1[r])); }
            mt = xmax32(xmax16(mt)) * sc;
            const float mn = fmaxf(m, mt);
            if (__any(mn > m + 8.0f)) { const float al = fexp2(m - mn); l *= al;
#pragma unroll
                for (int d = 0; d < 16; ++d) O[d] *= al;
                m = mn; }
            float ps = 0.f;
#pragma unroll
            for (int r = 0; r < 4; ++r) { S0[r] = fexp2(__builtin_fmaf(S0[r], sc, -m)); S1[r] = fexp2(__builtin_fmaf(S1[r], sc, -m)); ps += S0[r] + S1[r]; }
            l += ps;
            u32x4 pw; pw.x = cvt_pk_bf16(S0[0], S0[1]); pw.y = cvt_pk_bf16(S0[2], S0[3]); pw.z = cvt_pk_bf16(S1[0], S1[1]); pw.w = cvt_pk_bf16(S1[2], S1[3]);
            const bf16x8 pf = __builtin_bit_cast(bf16x8, pw);
            {
                const int qq = (lane & 15) >> 2, pp = lane & 3;
                const LAS unsigned char* vb = buf + (4 * g + qq) * RP + (4 * pp) * 2;
                __builtin_amdgcn_s_setprio(1);
#pragma unroll
                for (int d = 0; d < 16; ++d) {
                    const s16x4 lo = __builtin_amdgcn_ds_read_tr16_b64_v4i16((LAS s16x4*)(vb + d * 32));
                    const s16x4 h4 = __builtin_amdgcn_ds_read_tr16_b64_v4i16((LAS s16x4*)(vb + 16 * RP + d * 32));
                    const bf16x8 vf = (bf16x8){lo[0], lo[1], lo[2], lo[3], h4[0], h4[1], h4[2], h4[3]};
                    O[d] = __builtin_amdgcn_mfma_f32_16x16x32_bf16(vf, pf, O[d], 0, 0, 0);
                }
                __builtin_amdgcn_sched_group_barrier(0x100, 4, 0);
#pragma unroll
                for (int i = 0; i < 14; ++i) { __builtin_amdgcn_sched_group_barrier(0x008, 1, 0); __builtin_amdgcn_sched_group_barrier(0x100, 2, 0); }
                __builtin_amdgcn_sched_group_barrier(0x008, 2, 0);
                __builtin_amdgcn_s_setprio(0);
            }
        }
        l = xsum32(xsum16(l));
        const float il = 1.0f / l;
        { int lo_ = lane_id(); asm volatile("" : "+v"(lo_));
          asm volatile("" ::: "memory");
          if ((lo_ & 15) < 8) {
              LAS unsigned char* sp = buf + (lo_ & 15) * 528 + 8 * (lo_ >> 4);
#pragma unroll
              for (int d = 0; d < 16; ++d) { u32x2 w; w.x = cvt_pk_bf16(O[d][0] * il, O[d][1] * il); w.y = cvt_pk_bf16(O[d][2] * il, O[d][3] * il); *(LAS u32x2*)(sp + 32 * d) = w; }
          }
          asm volatile("" ::: "memory");
          bf16_t* o = OA + (size_t)tok * LDOA + (lo_ >> 5) * 256 + (lo_ & 31) * 8;
#pragma unroll
          for (int i = 0; i < 4; ++i) { const u32x4 v = *(const LAS u32x4*)(buf + (2 * i + (lo_ >> 5)) * 528 + (lo_ & 31) * 16); *(GAS u32x4*)(o + i * 512) = v; }
          asm volatile("" ::: "memory"); }
    }
}

#undef SA_GATHER
__device__ __forceinline__ void glu_phase(const Ctx& c0, unsigned char* ws, const float* cw, const float* cb) {
    const Ctx c = launder(c0);
    const bf16_t* AH = (const bf16_t*)(ws + WS_AH); bf16_t* BH = (bf16_t*)(ws + WS_BH);
    const int gt = c.gw * 64 + c.lane, NGT = c.NGW * 64;
    constexpr int CV = FF / 8;
    for (int i = gt; i < 16384 * CV; i += NGT) {
        const int r = i / CV, cv = i % CV, col = cv * 8, t = r & 4095;
        const u32x4 a0 = *(const GAS u32x4*)(AH + (size_t)r * FF + col);
        const u32x4 a1 = (t >= 1) ? *(const GAS u32x4*)(AH + (size_t)(r - 1) * FF + col) : (u32x4){0u, 0u, 0u, 0u};
        const u32x4 a2 = (t >= 2) ? *(const GAS u32x4*)(AH + (size_t)(r - 2) * FF + col) : (u32x4){0u, 0u, 0u, 0u};
        const u32x4 bb = *(const GAS u32x4*)(BH + (size_t)r * FF + col);
        float w0[8], w1[8], w2[8], bi[8];
#pragma unroll
        for (int e = 0; e < 2; ++e) { const f32x4 x0 = *(const GAS f32x4*)(cw + col + 4 * e), x1 = *(const GAS f32x4*)(cw + FF + col + 4 * e), x2 = *(const GAS f32x4*)(cw + 2 * FF + col + 4 * e), x3 = *(const GAS f32x4*)(cb + col + 4 * e);
#pragma unroll
            for (int q = 0; q < 4; ++q) { w0[4 * e + q] = x0[q]; w1[4 * e + q] = x1[q]; w2[4 * e + q] = x2[q]; bi[4 * e + q] = x3[q]; } }
        u32x4 o;
#pragma unroll
        for (int e = 0; e < 4; ++e) {
            const float c0 = w0[2 * e] * bflo(a2[e]) + w1[2 * e] * bflo(a1[e]) + w2[2 * e] * bflo(a0[e]) + bi[2 * e];
            const float c1 = w0[2 * e + 1] * bfhi(a2[e]) + w1[2 * e + 1] * bfhi(a1[e]) + w2[2 * e + 1] * bfhi(a0[e]) + bi[2 * e + 1];
            const float g0 = c0 * __builtin_amdgcn_rcpf(1.0f + fexp2(-c0 * LOG2E)) * bflo(bb[e]);
            const float g1 = c1 * __builtin_amdgcn_rcpf(1.0f + fexp2(-c1 * LOG2E)) * bfhi(bb[e]);
            o[e] = cvt_pk_bf16(g0, g1);
        }
        *(GAS u32x4*)(BH + (size_t)r * FF + col) = o;
    }
}

__global__ void __launch_bounds__(NTHR, 2) fwd_kernel(Args a_unused) {
    extern __shared__ __attribute__((aligned(16))) unsigned char lds_raw[];
    Ctx c;
    c.lds = (LAS unsigned char*)lds_raw;
    c.tid = threadIdx.x; c.lane = c.tid & 63; c.wave = __builtin_amdgcn_readfirstlane(c.tid >> 6);
    c.G = gridDim.x; { const int bx = blockIdx.x; c.vcu = (c.G % 8 == 0) ? (bx % 8) * (c.G / 8) + bx / 8 : bx; }
    c.gw = c.vcu * NWAVES + c.wave; c.NGW = c.G * NWAVES;
    volatile LAS unsigned* MISC = (volatile LAS unsigned*)(c.lds + MISC_OFF);
    if (c.tid < 32) MISC[c.tid] = 0u;
    __syncthreads();
    unsigned char* ws = gptr(argp()->ws);
    XcdBarrier bar = xcd_barrier_post((unsigned*)(ws + WS_CTL) + CW_BAR, MISC + 8); bar.wave = c.wave;
    int ph = 0;
    const int lo = argp()->ph_lo, hi = argp()->ph_hi;
#define PHASE_BEGIN if (ph >= lo && ph < hi) {
#define PHASE_END   if (ph + 1 < hi) xcd_barrier(bar); } ++ph;

    PHASE_BEGIN prologue1(c); PHASE_END
    PHASE_BEGIN prologue2(c, ws); PHASE_END

#pragma nounroll
    for (int l = 0; l < DEPTH; ++l) {
        asm volatile("" : "+s"(ws)); ws = gptr(ws);
        const int kind = l % 3, j = l / 3;
        unsigned char* wl = ws + WS_WT + (size_t)l * WT_LAYER;
        const bf16_t* kvm = (const bf16_t*)(ws + WS_KVM + (size_t)l * 2 * MiB);
        PHASE_BEGIN
        { const int N = kind == 0 ? NA_IN : kind == 1 ? NB_IN : NC_IN;
          pg8::Gemm g{(const bf16_t*)(ws + WS_XN), (const bf16_t*)(wl + WT_IN), DM, DM, DM}; pg8::StaticOrder S; S.init(MTOK, N, c.G, (int)blockIdx.x);
          EpiIn E{kind, ws, c.lds + 8 * pg8::HTB, (const float*)(ws + WS_SSP)}; pg8::gemm_phase<EpiIn, pg8::StaticOrder>(c.lds, g, S, E, c.wave); }
        PHASE_END
        if (kind == 0) {
            PHASE_BEGIN
            ckv_norm_rows(c, ws, gptr(argp()->a_kv_norm) + (size_t)j * 256);
            mem_attn_units(c, (bf16_t*)(ws + WS_OA), LDOA, 2048, kvm);
            __syncthreads();
            indexer_phase(c, ws);
            PHASE_END
            PHASE_BEGIN sparse_attn_phase(c, ws); PHASE_END
        } else if (kind == 1) {
            PHASE_BEGIN
            mem_attn_units(c, (bf16_t*)(ws + WS_OB), LDOB, 1024, kvm);
            swa_units(c, ws, gptr(argp()->b_sinks) + (size_t)j * 16);
            PHASE_END
        } else {
            PHASE_BEGIN
            mem_attn_units(c, (bf16_t*)(ws + WS_OC), LDOB, 1024, kvm);
            dil_units(c, ws, (bf16_t*)gptr(argp()->out), 0, 2);
            PHASE_END
            PHASE_BEGIN dil_units(c, ws, (bf16_t*)gptr(argp()->out), 2, 3); PHASE_END
        }
        PHASE_BEGIN
        { const int K = kind == 0 ? LDOA : LDOB;
          pg8::Gemm g{(const bf16_t*)(ws + WS_ACT), (const bf16_t*)(wl + WT_OUT), K, K, K}; pg8::StaticOrder S; S.init(MTOK, DM, c.G, (int)blockIdx.x);
          EpiRes E{(bf16_t*)(ws + WS_XN), (float*)(ws + WS_SSP)}; pg8::gemm_phase<EpiRes, pg8::StaticOrder>(c.lds, g, S, E, c.wave); }
        PHASE_END
        PHASE_BEGIN
        { pg8::Gemm g{(const bf16_t*)(ws + WS_XN), (const bf16_t*)(wl + WT_UP), DM, DM, DM}; pg8::OvlOrder S; S.init(BATCH * 17, 22, c.G, (int)blockIdx.x);
          EpiGlu E{(bf16_t*)(ws + WS_G), (const float*)(ws + WS_SSP), gptr(argp()->f_conv_w) + (size_t)l * 3 * FF, gptr(argp()->f_conv_b) + (size_t)l * FF, c.lds + 8 * pg8::HTB};
          pg8::gemm_phase<EpiGlu, pg8::OvlOrder>(c.lds, g, S, E, c.wave); }
        PHASE_END
        PHASE_BEGIN
        { pg8::Gemm g{(const bf16_t*)(ws + WS_G), (const bf16_t*)(wl + WT_DOWN), FF, FF, FF}; pg8::StaticOrder S; S.init(MTOK, DM, c.G, (int)blockIdx.x);
          EpiRes E{(bf16_t*)(ws + WS_XN), (float*)(ws + WS_SSP)}; pg8::gemm_phase<EpiRes, pg8::StaticOrder>(c.lds, g, S, E, c.wave); }
        PHASE_END
    }
    if (ph >= lo && ph < hi) final_norm_phase(c, (const bf16_t*)(ws + WS_XN), (const float*)(ws + WS_SSP), gptr(argp()->g_final), gptr(argp()->out));
#undef PHASE_BEGIN
#undef PHASE_END
}

extern "C" void kernel_launch(void* const* d_in, const int* in_sizes, int n_in, void* d_out, int out_size, void* d_ws, size_t ws_size, hipStream_t stream) {
    static int grid = 0;
    if (grid == 0) {
        if (n_in != 22 || ws_size < WS_END) { fprintf(stderr, "kernel_launch: unexpected n_in %d or ws_size %zu\n", n_in, ws_size); grid = -1; return; }
        int dev = 0, cus = 0, per_cu = 0;
        if (hipGetDevice(&dev) != hipSuccess || hipDeviceGetAttribute(&cus, hipDeviceAttributeMultiprocessorCount, dev) != hipSuccess) { grid = -1; return; }
        if (hipFuncSetAttribute((const void*)fwd_kernel, hipFuncAttributeMaxDynamicSharedMemorySize, LDS_BYTES) != hipSuccess) { fprintf(stderr, "kernel_launch: hipFuncSetAttribute failed\n"); grid = -1; return; }
        if (hipOccupancyMaxActiveBlocksPerMultiprocessor(&per_cu, (const void*)fwd_kernel, NTHR, LDS_BYTES) != hipSuccess || per_cu < 1)
            fprintf(stderr, "kernel_launch: occupancy query reports %d\n", per_cu);
        (void)hipGetLastError();
        grid = cus;
    }
    if (grid < 0) return;
    (void)hipMemsetAsync((char*)d_ws + WS_CTL, 0, CTL_ZERO_BYTES, stream);
    Args a{};
    a.x = (const float*)d_in[0]; a.mem = (const float*)d_in[1]; a.positions = (const int*)d_in[2];
    a.g_mix = (const float*)d_in[3]; a.g_ffn = (const float*)d_in[4]; a.g_mem = (const float*)d_in[5]; a.g_final = (const float*)d_in[6]; a.w_mem_kv = (const float*)d_in[7];
    a.a_w_in = (const float*)d_in[8]; a.a_kv_norm = (const float*)d_in[9]; a.a_w_uk = (const float*)d_in[10]; a.a_w_uv = (const float*)d_in[11]; a.a_w_out = (const float*)d_in[12];
    a.b_w_in = (const float*)d_in[13]; a.b_sinks = (const float*)d_in[14]; a.b_w_out = (const float*)d_in[15]; a.c_w_in = (const float*)d_in[16]; a.c_w_out = (const float*)d_in[17];
    a.f_w_up = (const float*)d_in[18]; a.f_conv_w = (const float*)d_in[19]; a.f_conv_b = (const float*)d_in[20]; a.f_w_down = (const float*)d_in[21];
    a.out = (float*)d_out; a.ws = (unsigned char*)d_ws;
    a.ph_lo = 0; a.ph_hi = 1000;
    hipLaunchKernelGGL(fwd_kernel, dim3(grid), dim3(NTHR), LDS_BYTES, stream, a);
}
```

```cpp
#include <hip/hip_runtime.h>
#include <cstdio>
#include <cstdint>
#include <cmath>

#define LAS __attribute__((address_space(3)))
#define GAS __attribute__((address_space(1)))
typedef unsigned short bf16_t;
typedef short bf16x8 __attribute__((ext_vector_type(8)));
typedef short s16x4 __attribute__((ext_vector_type(4)));
typedef float f32x4 __attribute__((ext_vector_type(4)));
typedef float f32x2 __attribute__((ext_vector_type(2)));
typedef float f32x16 __attribute__((ext_vector_type(16)));
typedef unsigned u32x4 __attribute__((ext_vector_type(4)));
typedef unsigned u32x2 __attribute__((ext_vector_type(2)));
typedef GAS unsigned gu32;

constexpr int BATCH = 8, SEQ = 4096, DM = 1024, MTOK = BATCH * SEQ, DEPTH = 4, FF = 2816, MEMLEN = 256;
constexpr int NWAVES = 8, NTHR = 512;
constexpr float EPS = 1e-6f;
constexpr float LOG2E = 1.4426950408889634f;
constexpr float NEGBIG = -1e30f;
constexpr float MASKV = -3.0e38f;
constexpr int NA_IN = 4096, NB_IN = 1792, NC_IN = 3328;
constexpr int LDOA = 2304, LDOB = 1280;
constexpr int CKVP = 288;

constexpr size_t MiB = 1u << 20;
constexpr size_t WS_CTL = 0, CTL_ZERO_BYTES = 1 * MiB;
constexpr size_t WS_COS32 = 1 * MiB, WS_SIN32 = 3 * MiB, WS_COS16 = 5 * MiB, WS_SIN16 = 6 * MiB;
constexpr size_t WS_MEMN = 7 * MiB;
constexpr size_t WS_KVM = 11 * MiB;
constexpr size_t WS_WT = 20 * MiB, WT_LAYER = 32 * MiB;
constexpr size_t WT_UP = 0, WT_DOWN = 11 * MiB, WT_MKV = 17 * MiB, WT_OUT = 18 * MiB, WT_IN = 23 * MiB;
constexpr size_t WS_XN = 148 * MiB;
constexpr size_t WS_ACT = 212 * MiB;
constexpr size_t WS_OA = WS_ACT, WS_QR = WS_ACT + 144 * MiB, WS_CKV = WS_ACT + 160 * MiB, WS_KI = WS_ACT + 178 * MiB, WS_WI = WS_ACT + 182 * MiB,
                 WS_QI = WS_ACT + 184 * MiB, WS_IDX = WS_ACT + 248 * MiB, WS_TMP = WS_ACT + 264 * MiB;
constexpr size_t WS_OB = WS_ACT, WS_KB = WS_ACT + 80 * MiB, WS_VB = WS_ACT + 96 * MiB;
constexpr size_t WS_OC = WS_ACT, WS_KC = WS_ACT + 80 * MiB, WS_VC = WS_ACT + 144 * MiB, WS_P2 = WS_ACT + 208 * MiB, WS_LSE = WS_ACT + 272 * MiB;
constexpr size_t WS_AH = WS_ACT, WS_BH = WS_ACT + 88 * MiB;
constexpr size_t WS_G = WS_ACT;
constexpr size_t WS_SSP = 508 * MiB;
constexpr size_t WS_END = 512 * MiB;
constexpr size_t TMP_STRIDE = 16 * MiB, TMP_WNAT = 0, TMP_WUKT = 6 * MiB, TMP_WUVN = 7 * MiB, TMP_WOT = 8 * MiB;

constexpr int CW_TMO = 0, CW_BAR = 4096;

constexpr int LDS_BYTES = 159744;
constexpr int MISC_OFF = 155648;

__device__ __forceinline__ unsigned f2bf(float f) { unsigned u = __builtin_bit_cast(unsigned, f); return (u + 0x7fffu + ((u >> 16) & 1u)) >> 16; }
__device__ __forceinline__ unsigned cvt_pk_bf16(float lo, float hi) { unsigned r; asm volatile("v_cvt_pk_bf16_f32 %0, %1, %2" : "=v"(r) : "v"(lo), "v"(hi)); return r; }
__device__ __forceinline__ float bf2f(unsigned short b) { return __builtin_bit_cast(float, (unsigned)b << 16); }
__device__ __forceinline__ float bflo(unsigned w) { return __builtin_bit_cast(float, w << 16); }
__device__ __forceinline__ float bfhi(unsigned w) { return __builtin_bit_cast(float, w & 0xffff0000u); }
__device__ __forceinline__ float wave_max(float v) {
#pragma unroll
    for (int o = 1; o < 64; o <<= 1) v = fmaxf(v, __shfl_xor(v, o));
    return v;
}
__device__ __forceinline__ float wave_min(float v) {
#pragma unroll
    for (int o = 1; o < 64; o <<= 1) v = fminf(v, __shfl_xor(v, o));
    return v;
}
__device__ __forceinline__ float fexp2(float x) { return __builtin_amdgcn_exp2f(x); }
__device__ __forceinline__ float xmax16(float v) { const unsigned u = __builtin_bit_cast(unsigned, v); const auto r = __builtin_amdgcn_permlane16_swap(u, u, false, false); const unsigned r0 = r[0], r1 = r[1]; const float a = __builtin_bit_cast(float, r0), b = __builtin_bit_cast(float, r1); return fmaxf(a, b); }
__device__ __forceinline__ float xmax32(float v) { const unsigned u = __builtin_bit_cast(unsigned, v); const auto r = __builtin_amdgcn_permlane32_swap(u, u, false, false); const unsigned r0 = r[0], r1 = r[1]; const float a = __builtin_bit_cast(float, r0), b = __builtin_bit_cast(float, r1); return fmaxf(a, b); }
__device__ __forceinline__ float xsum16(float v) { const unsigned u = __builtin_bit_cast(unsigned, v); const auto r = __builtin_amdgcn_permlane16_swap(u, u, false, false); const unsigned r0 = r[0], r1 = r[1]; const float a = __builtin_bit_cast(float, r0), b = __builtin_bit_cast(float, r1); return a + b; }
__device__ __forceinline__ float xsum32(float v) { const unsigned u = __builtin_bit_cast(unsigned, v); const auto r = __builtin_amdgcn_permlane32_swap(u, u, false, false); const unsigned r0 = r[0], r1 = r[1]; const float a = __builtin_bit_cast(float, r0), b = __builtin_bit_cast(float, r1); return a + b; }
__device__ __forceinline__ float wave_sum(float v) {
    v += __builtin_bit_cast(float, __builtin_amdgcn_mov_dpp(__builtin_bit_cast(int, v), 0xB1, 0xf, 0xf, false));
    v += __builtin_bit_cast(float, __builtin_amdgcn_mov_dpp(__builtin_bit_cast(int, v), 0x4E, 0xf, 0xf, false));
    v += __builtin_bit_cast(float, __builtin_amdgcn_mov_dpp(__builtin_bit_cast(int, v), 0x141, 0xf, 0xf, false));
    v += __builtin_bit_cast(float, __builtin_amdgcn_mov_dpp(__builtin_bit_cast(int, v), 0x140, 0xf, 0xf, false));
    return xsum32(xsum16(v));
}
#define DPPF(v_, ctl_) __builtin_bit_cast(float, __builtin_amdgcn_mov_dpp(__builtin_bit_cast(int, (v_)), (ctl_), 0xf, 0xf, false))
__device__ __forceinline__ float half_min(float v) {
    v = fminf(v, DPPF(v, 0xB1)); v = fminf(v, DPPF(v, 0x4E)); v = fminf(v, DPPF(v, 0x141)); v = fminf(v, DPPF(v, 0x140));
    const unsigned u = __builtin_bit_cast(unsigned, v); const auto r = __builtin_amdgcn_permlane16_swap(u, u, false, false); const unsigned r0 = r[0], r1 = r[1];
    return fminf(__builtin_bit_cast(float, r0), __builtin_bit_cast(float, r1));
}
__device__ __forceinline__ float half_max(float v) {
    v = fmaxf(v, DPPF(v, 0xB1)); v = fmaxf(v, DPPF(v, 0x4E)); v = fmaxf(v, DPPF(v, 0x141)); v = fmaxf(v, DPPF(v, 0x140));
    return xmax16(v);
}
__device__ __forceinline__ int crow(int r, int hi) { return (r & 3) + 8 * (r >> 2) + 4 * hi; }

#define XB_TMO      128
#define XB_XCNT(j)  (256  + 64 * (j))
#define XB_XSUB(j)  (1280 + 64 * (j))
#define XB_XGEN(j)  (2304 + 64 * (j))
#define XB_TOP      3328
#define XB_TOPGEN   3392
#define XCD_BAR_WORDS 3456
#define XB_SPIN_CAP (1u << 22)

__device__ __forceinline__ unsigned xb_ld(unsigned* p)              { return __hip_atomic_load(p, __ATOMIC_RELAXED, __HIP_MEMORY_SCOPE_AGENT); }
__device__ __forceinline__ unsigned xb_add(unsigned* p, unsigned v) { return __hip_atomic_fetch_add(p, v, __ATOMIC_RELAXED, __HIP_MEMORY_SCOPE_AGENT); }
__device__ __forceinline__ unsigned xb_xcc_id() { return (unsigned)__builtin_amdgcn_s_getreg((3 << 11) | 20) & 0xFu; }
#define XB_SPIN(cond, bar) do { unsigned _sp = 0; while (cond) { __builtin_amdgcn_s_sleep(1); \
    if ((++_sp & 255u) == 0u) { if (xb_ld(&(bar)[XB_TMO])) break; if (_sp > XB_SPIN_CAP) { atomicAdd(&(bar)[XB_TMO], 1u); break; } } } } while (0)

struct XcdBarrier { unsigned* bar; unsigned x; volatile LAS unsigned* st; int wave; };

__device__ __forceinline__ XcdBarrier xcd_barrier_post(unsigned* bar, volatile LAS unsigned* st) {
    XcdBarrier b; b.bar = bar; b.x = xb_xcc_id(); b.st = st;
    if (threadIdx.x == 0) (void)xb_add(&bar[XB_XCNT(b.x)], 1u);
    return b;
}
__device__ __forceinline__ void xcd_barrier_complete(unsigned* bar, unsigned x, unsigned& nloc, unsigned& nx) {
    const unsigned G = gridDim.x * gridDim.y * gridDim.z;
    unsigned sum, cnt, mine, sp = 0u;
    for (;;) {
        sum = 0u; cnt = 0u; mine = 0u;
#pragma unroll
        for (unsigned j = 0; j < 16; ++j) { const unsigned c = xb_ld(&bar[XB_XCNT(j)]); sum += c; cnt += (c > 0u) ? 1u : 0u; mine = (j == x) ? c : mine; }
        if (sum == G) break;
        __builtin_amdgcn_s_sleep(1);
        if ((++sp & 255u) == 0u) { if (xb_ld(&bar[XB_TMO])) break; if (sp > XB_SPIN_CAP) { atomicAdd(&bar[XB_TMO], 1u); break; } }
    }
    nloc = mine > 0u ? mine : 1u; nx = cnt > 0u ? cnt : 1u;
}
__device__ __forceinline__ void xcd_barrier(const XcdBarrier& b) {
    asm volatile("s_waitcnt vmcnt(0)" ::: "memory");
    __syncthreads();
    int bl_; asm volatile("v_mbcnt_lo_u32_b32 %0, -1, 0\n\tv_mbcnt_hi_u32_b32 %0, -1, %0" : "=v"(bl_));
    if (b.wave == 0 && bl_ == 0) {
        unsigned* bar = b.bar;
        __builtin_amdgcn_s_waitcnt(0);
        unsigned nloc = b.st[0], nx = b.st[1];
        if (nloc == 0u) { xcd_barrier_complete(bar, b.x, nloc, nx); b.st[0] = nloc; b.st[1] = nx; }
        const unsigned old = xb_add(&bar[XB_XSUB(b.x)], 1u);
        const unsigned gen = old / nloc;
        if (old + 1u == (gen + 1u) * nloc) {
            __builtin_amdgcn_fence(__ATOMIC_RELEASE, "agent");
            asm volatile("s_waitcnt vmcnt(0)" ::: "memory");
            const unsigned og = xb_add(&bar[XB_TOP], 1u);
            const unsigned tg = og / nx;
            if (og + 1u == (tg + 1u) * nx) xb_add(&bar[XB_TOPGEN], 1u);
            else XB_SPIN(xb_ld(&bar[XB_TOPGEN]) == tg, bar);
            __builtin_amdgcn_fence(__ATOMIC_ACQUIRE, "agent");
            xb_add(&bar[XB_XGEN(b.x)], 1u);
            asm volatile("s_waitcnt vmcnt(0)" ::: "memory");
        } else {
            XB_SPIN(xb_ld(&bar[XB_XGEN(b.x)]) == gen, bar);
            __builtin_amdgcn_fence(__ATOMIC_ACQUIRE, "agent");
            asm volatile("s_waitcnt vmcnt(0)" ::: "memory");
        }
    }
    __syncthreads();
}

namespace pg8 {
constexpr int BM = 256, BK = 64, HALF = 128, HTB = HALF * BK * 2, STAGE_BYTES = 8 * HTB, NXCD = 8, WGM = 8;
__device__ __forceinline__ int lds_byte(int r, int c) { const int st = (r >> 4) * 2 + (c >> 5), rr = r & 15, cc = c & 31, ob = rr * 64 + cc * 2; return st * 1024 + (ob ^ (((ob >> 9) & 1) << 5)); }
__device__ __forceinline__ void stage_rc(int b, int& R, int& C) { const int st = b / 1024, sb = b % 1024, swz = sb ^ (((sb >> 9) & 1) << 5); R = (st >> 1) * 16 + swz / 64; C = (st & 1) * 32 + (swz % 64) / 2; }
__device__ __forceinline__ int perm32(int rho) { const int n = rho >> 4, i = rho & 15; return 8 * (i >> 2) + 4 * n + (i & 3); }

struct Unit { int pm, pn; };
struct Gemm { const bf16_t* A; const bf16_t* Bt; int lda, ldb, K; };

struct StaticOrder {
    static constexpr bool OVL = false;
    int nM, nN, nwg, G, c;
    __device__ __forceinline__ long arow(const Unit& u) const { return (long)u.pm * BM; }
    __device__ void init(int M, int N, int G_, int c_) { nM = M / BM; nN = N / BM; nwg = nM * nN; G = G_; c = c_; }
    __device__ bool next(int i, Unit& u) const {
        const long L = (long)i * G + c; if (L >= nwg) return false;
        int wgid = (int)L; { const int q = nwg / NXCD, r = nwg % NXCD, xcd = wgid % NXCD, off = wgid / NXCD; wgid = (xcd < r ? xcd * (q + 1) : r * (q + 1) + (xcd - r) * q) + off; }
        const int nig = WGM * nN, gid = wgid / nig, fm = gid * WGM, gsz = (nM - fm) < WGM ? (nM - fm) : WGM;
        u.pm = fm + ((wgid % nig) % gsz); u.pn = (wgid % nig) / gsz; return true;
    }
};
struct OvlOrder {
    static constexpr bool OVL = true;
    int nM, nN, nwg, G, c;
    __device__ void init(int nM_, int nN_, int G_, int c_) { nM = nM_; nN = nN_; nwg = nM * nN; G = G_; c = c_; }
    __device__ bool next(int i, Unit& u) const {
        const long L = (long)i * G + c; if (L >= nwg) return false;
        int wgid = (int)L; { const int q = nwg / NXCD, r = nwg % NXCD, xcd = wgid % NXCD, off = wgid / NXCD; wgid = (xcd < r ? xcd * (q + 1) : r * (q + 1) + (xcd - r) * q) + off; }
        const int nig = WGM * nN, gid = wgid / nig, fm = gid * WGM, gsz = (nM - fm) < WGM ? (nM - fm) : WGM;
        u.pm = fm + ((wgid % nig) % gsz); u.pn = (wgid % nig) / gsz; return true;
    }
    __device__ __forceinline__ long arow(const Unit& u) const { return (long)(u.pm / 17) * 4096 + 248 * (u.pm % 17) - 2; }
};
struct OneUnit {
    static constexpr bool OVL = false;
    __device__ __forceinline__ long arow(const Unit& u) const { return (long)u.pm * BM; }
    int pm, pn; bool have;
    __device__ bool next(int i, Unit& u) const { if (i > 0 || !have) return false; u.pm = pm; u.pn = pn; return true; }
};

template <class Epi, class Sched>
__device__ __forceinline__ void gemm_phase(LAS unsigned char* lds, const Gemm g, const Sched& S, const Epi& E, int wave_) {
    int tid_; asm volatile("v_mbcnt_lo_u32_b32 %0, -1, 0\n\tv_mbcnt_hi_u32_b32 %0, -1, %0" : "=v"(tid_)); tid_ += wave_ * 64;
    const int tid = tid_, wid = __builtin_amdgcn_readfirstlane(tid >> 6), lane = tid & 63, wr = wid >> 2, wc = wid & 3, fr = lane & 15, fq = lane >> 4;
    const int K = g.K, nt = K / BK;
    unsigned voffA[2], voffB[2];
#pragma unroll
    for (int i = 0; i < 2; ++i) { int R, C; stage_rc(tid * 16 + i * 8192, R, C); const int Rb = Epi::PERM ? ((R & ~31) + perm32(R & 31)) : R;
        const int Ra = Sched::OVL ? 62 * (R >> 6) + 4 * (R & 15) + ((R >> 4) & 3) : R;
        voffA[i] = (unsigned)(Ra * g.lda + C) * 2u; voffB[i] = (unsigned)(Rb * g.ldb + C) * 2u; }
    const size_t kstep = (size_t)(BK * 2);
    const size_t hstepA = (size_t)(Sched::OVL ? HALF - 4 : HALF) * g.lda * 2, hstepB = (size_t)HALF * g.ldb * 2;
    const size_t tstepB = 2 * hstepB; const long rowbA = (long)g.lda * 2;
    const unsigned ldsw = (unsigned)wid * 1024u;
    const int aoff = lds_byte(wr * 64 + fr, fq * 8), boff = lds_byte(wc * 32 + fr, fq * 8);
#define PG8_SA(b, h) (((b) * 2 + (h)) * HTB)
#define PG8_SB(b, h) ((4 + (b) * 2 + (h)) * HTB)
#define PG8_STAGE(bufoff, gbase, voff) do { _Pragma("unroll") for (int _i = 0; _i < 2; ++_i) \
        __builtin_amdgcn_global_load_lds((const unsigned*)((const char*)(gbase) + (voff)[_i]), (LAS unsigned*)(lds + (bufoff) + ldsw + _i * 8192), 16, 0, 0); } while (0)
#define PG8_LDA(dst, b, h) do { _Pragma("unroll") for (int m = 0; m < 4; ++m) _Pragma("unroll") for (int k = 0; k < 2; ++k) dst[m][k] = *(const LAS bf16x8*)(lds + PG8_SA(b, h) + aoff + m * 2048 + k * 1024); } while (0)
#define PG8_LDB(dst, b, h) do { _Pragma("unroll") for (int n = 0; n < 2; ++n) _Pragma("unroll") for (int k = 0; k < 2; ++k) dst[n][k] = *(const LAS bf16x8*)(lds + PG8_SB(b, h) + boff + n * 2048 + k * 1024); } while (0)
#define PG8_MMA(ai, bj, At, Bt) do { __builtin_amdgcn_s_setprio(1); _Pragma("unroll") for (int m = 0; m < 4; ++m) _Pragma("unroll") for (int n = 0; n < 2; ++n) _Pragma("unroll") for (int k = 0; k < 2; ++k) \
        acc[ai][bj][m][n] = __builtin_amdgcn_mfma_f32_16x16x32_bf16(Bt[n][k], At[m][k], acc[ai][bj][m][n], 0, 0, 0); __builtin_amdgcn_s_setprio(0); } while (0)
#define PG8_WAIT_V(n) asm volatile("s_waitcnt vmcnt(" #n ")" ::: "memory")
#define PG8_WAIT_L(n) asm volatile("s_waitcnt lgkmcnt(" #n ")" ::: "memory")
#define PG8_BAR __builtin_amdgcn_s_barrier()
#define PG8_SCHED __builtin_amdgcn_sched_barrier(0)
    Unit cur, nxt; int ui = 0;
    if (!S.next(0, cur)) return;
    f32x4 acc[2][2][4][2];
#pragma unroll
    for (int a = 0; a < 2; ++a)
#pragma unroll
        for (int b = 0; b < 2; ++b)
#pragma unroll
            for (int m = 0; m < 4; ++m)
#pragma unroll
                for (int n = 0; n < 2; ++n) acc[a][b][m][n] = (f32x4){0.f, 0.f, 0.f, 0.f};
    bf16x8 At[4][2], B0[2][2], B1[2][2];
    const char* cA = (const char*)g.A + S.arow(cur) * rowbA; const char* cB = (const char*)g.Bt + (size_t)cur.pn * tstepB;
    PG8_STAGE(PG8_SB(0, 0), cB, voffB); PG8_STAGE(PG8_SB(0, 1), cB + hstepB, voffB); PG8_STAGE(PG8_SA(0, 0), cA, voffA); PG8_STAGE(PG8_SA(0, 1), cA + hstepA, voffA);
    if (wr == 1) PG8_BAR;
    PG8_WAIT_V(2); PG8_BAR;
    PG8_STAGE(PG8_SB(1, 0), cB + kstep, voffB); PG8_STAGE(PG8_SA(1, 0), cA + kstep, voffA); PG8_STAGE(PG8_SB(1, 1), cB + hstepB + kstep, voffB);
    PG8_WAIT_V(6); PG8_BAR;
    for (;;) {
        const bool has_next = S.next(ui + 1, nxt);
        if constexpr (Epi::PREFETCH) { PG8_BAR; E.prefetch(lds + 8 * HTB, S.arow(cur), cur, wid, lane); }
        const char* nA = has_next ? (const char*)g.A + S.arow(nxt) * rowbA : cA; const char* nB = has_next ? (const char*)g.Bt + (size_t)nxt.pn * tstepB : cB;
        for (int t = 0; t < nt; t += 2) {
            const bool last = (t == nt - 2);
            const char* a1 = cA + (size_t)(t + 1) * kstep;
            const char* a2 = last ? nA : cA + (size_t)(t + 2) * kstep; const char* b2 = last ? nB : cB + (size_t)(t + 2) * kstep;
            const char* a3 = a2 + kstep; const char* b3 = b2 + kstep;
            PG8_LDB(B0, 0, 0); PG8_LDB(B1, 0, 1); PG8_SCHED; PG8_LDA(At, 0, 0); PG8_STAGE(PG8_SA(1, 1), a1 + hstepA, voffA);
            PG8_WAIT_V(8); PG8_WAIT_L(0); PG8_BAR; PG8_MMA(0, 0, At, B0); PG8_MMA(0, 1, At, B1); PG8_BAR; PG8_SCHED;
            PG8_LDA(At, 0, 1); PG8_STAGE(PG8_SB(0, 0), b2, voffB); PG8_STAGE(PG8_SB(0, 1), b2 + hstepB, voffB); PG8_STAGE(PG8_SA(0, 0), a2, voffA);
            PG8_WAIT_V(8); PG8_WAIT_L(0); PG8_BAR; PG8_MMA(1, 0, At, B0); PG8_MMA(1, 1, At, B1); PG8_BAR; PG8_SCHED;
            PG8_LDB(B0, 1, 0); PG8_LDB(B1, 1, 1); PG8_SCHED; PG8_LDA(At, 1, 0); PG8_STAGE(PG8_SA(0, 1), a2 + hstepA, voffA);
            PG8_WAIT_V(8); PG8_WAIT_L(0); PG8_BAR; PG8_MMA(0, 0, At, B0); PG8_MMA(0, 1, At, B1); PG8_BAR; PG8_SCHED;
            PG8_LDA(At, 1, 1); PG8_STAGE(PG8_SB(1, 0), b3, voffB); PG8_STAGE(PG8_SB(1, 1), b3 + hstepB, voffB); PG8_STAGE(PG8_SA(1, 0), a3, voffA);
            PG8_WAIT_V(8); PG8_WAIT_L(0); PG8_BAR; PG8_MMA(1, 0, At, B0); PG8_MMA(1, 1, At, B1); PG8_BAR; PG8_SCHED;
        }
        if (wr == 0) PG8_BAR;
        E(acc, cur, wr, wc, fr, fq);
        if (!has_next) break;
#pragma unroll
        for (int a = 0; a < 2; ++a)
#pragma unroll
            for (int b = 0; b < 2; ++b)
#pragma unroll
                for (int m = 0; m < 4; ++m)
#pragma unroll
                    for (int n = 0; n < 2; ++n) acc[a][b][m][n] = (f32x4){0.f, 0.f, 0.f, 0.f};
        cur = nxt; cA = nA; cB = nB; ++ui;
        if (wr == 1) PG8_BAR;
    }
    PG8_WAIT_V(0);
    PG8_BAR;
#undef PG8_SA
#undef PG8_SB
#undef PG8_STAGE
#undef PG8_LDA
#undef PG8_LDB
#undef PG8_MMA
#undef PG8_WAIT_V
#undef PG8_WAIT_L
#undef PG8_BAR
#undef PG8_SCHED
}
}

struct EpiPlain {
    static constexpr bool PREFETCH = false;
    static constexpr bool PERM = true;
    bf16_t* O; bf16_t* O2; int ldc; int split;
    __device__ __forceinline__ void operator()(const f32x4 (&acc)[2][2][4][2], const pg8::Unit& u, int wr, int wc, int fr, int fq) const {
        bf16_t* base = (u.pn < split) ? O + u.pn * 256 : O2 + (u.pn - split) * 256;
        const int row0 = u.pm * 256 + wr * 64 + fr, col0 = wc * 32 + 8 * fq;
#pragma unroll
        for (int ai = 0; ai < 2; ++ai)
#pragma unroll
            for (int m = 0; m < 4; ++m) { bf16_t* rowp = base + (size_t)(row0 + ai * 128 + m * 16) * ldc + col0;
#pragma unroll
                for (int bj = 0; bj < 2; ++bj) { const f32x4 v0 = acc[ai][bj][m][0], v1 = acc[ai][bj][m][1];
                    u32x4 w; w.x = cvt_pk_bf16(v0[0], v0[1]); w.y = cvt_pk_bf16(v0[2], v0[3]); w.z = cvt_pk_bf16(v1[0], v1[1]); w.w = cvt_pk_bf16(v1[2], v1[3]);
                    *(GAS u32x4*)(rowp + bj * 128) = w; } }
    }
};
struct EpiRes {
    static constexpr bool PREFETCH = false;
    static constexpr bool PERM = true;
    bf16_t* xb; float* ssp;
    __device__ __forceinline__ void operator()(const f32x4 (&acc)[2][2][4][2], const pg8::Unit& u, int wr, int wc, int fr, int fq) const {
        const int row0 = u.pm * 256 + wr * 64 + fr, col0 = u.pn * 256 + wc * 32 + 8 * fq;
        u32x4 xo[2][4][2];
#pragma unroll
        for (int ai = 0; ai < 2; ++ai)
#pragma unroll
            for (int m = 0; m < 4; ++m)
#pragma unroll
                for (int bj = 0; bj < 2; ++bj) xo[ai][m][bj] = *(const GAS u32x4*)(xb + (size_t)(row0 + ai * 128 + m * 16) * DM + col0 + bj * 128);
        __builtin_amdgcn_sched_barrier(0);
#pragma unroll
        for (int ai = 0; ai < 2; ++ai)
#pragma unroll
            for (int m = 0; m < 4; ++m) { const int row = row0 + ai * 128 + m * 16; const size_t off = (size_t)row * DM + col0; float ss = 0.f;
#pragma unroll
                for (int bj = 0; bj < 2; ++bj) { const u32x4 bw = xo[ai][m][bj]; const f32x4 a0 = acc[ai][bj][m][0], a1 = acc[ai][bj][m][1];
                    u32x4 w; w.x = cvt_pk_bf16(bflo(bw.x) + a0[0], bfhi(bw.x) + a0[1]); w.y = cvt_pk_bf16(bflo(bw.y) + a0[2], bfhi(bw.y) + a0[3]);
                    w.z = cvt_pk_bf16(bflo(bw.z) + a1[0], bfhi(bw.z) + a1[1]); w.w = cvt_pk_bf16(bflo(bw.w) + a1[2], bfhi(bw.w) + a1[3]);
                    *(GAS u32x4*)(xb + off + bj * 128) = w;
#pragma unroll
                    for (int e = 0; e < 4; ++e) { const float v0 = bflo(w[e]), v1 = bfhi(w[e]); ss += v0 * v0 + v1 * v1; } }
                ss = xsum32(xsum16(ss));
                if (fq == 0) ((GAS float*)ssp)[(size_t)row * 16 + u.pn * 4 + wc] = ss; }
    }
};
__device__ __forceinline__ float row_rstd(const float* ssp, long row) {
    const GAS f32x4* sp = (const GAS f32x4*)(ssp + row * 16); const f32x4 s0 = sp[0], s1 = sp[1], s2 = sp[2], s3 = sp[3];
    const float ss = ((s0[0] + s0[1]) + (s0[2] + s0[3])) + ((s1[0] + s1[1]) + (s1[2] + s1[3])) + ((s2[0] + s2[1]) + (s2[2] + s2[3])) + ((s3[0] + s3[1]) + (s3[2] + s3[3]));
    return __builtin_amdgcn_rsqf(ss * (1.f / DM) + EPS);
}
__device__ __forceinline__ float row_rstd_q(const float* ssp, long row, int fq) {
    const f32x4 s = ((const GAS f32x4*)(ssp + row * 16))[fq];
    const float ss = xsum32(xsum16((s[0] + s[1]) + (s[2] + s[3])));
    return __builtin_amdgcn_rsqf(ss * (1.f / DM) + EPS);
}
__device__ __forceinline__ float rstd_from_q(const f32x4 s) { const float ss = xsum32(xsum16((s[0] + s[1]) + (s[2] + s[3]))); return __builtin_amdgcn_rsqf(ss * (1.f / DM) + EPS); }
template <int SH> __device__ __forceinline__ float row_shift(float cur, float prv) {
    const int t = __builtin_amdgcn_mov_dpp(__builtin_bit_cast(int, prv), 0x120 + SH, 0xf, 0xf, false);
    const int r = __builtin_amdgcn_update_dpp(t, __builtin_bit_cast(int, cur), 0x110 + SH, 0xf, 0xf, false);
    return __builtin_bit_cast(float, r);
}
template <int SH> __device__ __forceinline__ float row_shift0(float cur) {
    return __builtin_bit_cast(float, __builtin_amdgcn_update_dpp(0, __builtin_bit_cast(int, cur), 0x110 + SH, 0xf, 0xf, true));
}
struct EpiGlu {
    static constexpr bool PERM = true;
    static constexpr bool PREFETCH = true;
    bf16_t* G; const float* ssp; const float* cw; const float* cb;
    __device__ __forceinline__ void prefetch(LAS unsigned char* sp, long arow, const pg8::Unit& u, int wid, int lane_) const {
        int lane; asm volatile("v_mbcnt_lo_u32_b32 %0, -1, 0\n\tv_mbcnt_hi_u32_b32 %0, -1, %0" : "=v"(lane));
#pragma unroll
        for (int i = 0; i < 2; ++i) { long gr = arow + wid * 32 + 16 * i + (lane >> 2); gr = gr < 0 ? 0 : (gr < MTOK ? gr : MTOK - 1);
            __builtin_amdgcn_global_load_lds((const GAS unsigned*)(ssp + gr * 16 + (lane & 3) * 4), (LAS unsigned*)(sp + wid * 2048 + i * 1024), 16, 0, 0); }
        if (wid < 2) { const int q = wid * 64 + lane, a_ = q >> 5, c4 = q & 31; const float* src = (a_ < 3 ? cw + (size_t)a_ * FF : cb) + 128 * u.pn + 4 * c4;
            __builtin_amdgcn_global_load_lds((const GAS unsigned*)src, (LAS unsigned*)(sp + 16384 + wid * 1024), 16, 0, 0); }
    }
    LAS unsigned char* sp_;
    __device__ __forceinline__ void operator()(const f32x4 (&acc)[2][2][4][2], const pg8::Unit& u, int wr, int wc, int fr, int fq) const {
        const int b = u.pm / 17, jj = u.pm % 17, ch0 = 128 * u.pn + 32 * wc + 8 * fq;
        f32x4 w0[2], w1[2], w2[2], bi[2];
        asm volatile("" ::: "memory");
        int ln_; asm volatile("v_mbcnt_lo_u32_b32 %0, -1, 0\n\tv_mbcnt_hi_u32_b32 %0, -1, %0" : "=v"(ln_)); const int fr_ = ln_ & 15, fq_ = ln_ >> 4;
        { const LAS f32x4* wl = (const LAS f32x4*)(sp_ + 16384) + 8 * wc + 2 * fq_;
#pragma unroll
          for (int n = 0; n < 2; ++n) { w0[n] = wl[n]; w1[n] = wl[32 + n]; w2[n] = wl[64 + n]; bi[n] = wl[96 + n]; } }
        float rsa[2][4];
        { f32x4 pq[8];
#pragma unroll
          for (int k = 0; k < 8; ++k) pq[k] = *(const LAS f32x4*)(sp_ + (62 * (2 * (k >> 2) + wr) + 4 * fr_ + (k & 3)) * 64 + fq_ * 16);
          __builtin_amdgcn_sched_barrier(0);
#pragma unroll
          for (int k = 0; k < 8; ++k) { const int t = 248 * jj + 62 * (2 * (k >> 2) + wr) - 2 + 4 * fr + (k & 3); const float r_ = rstd_from_q(pq[k]); rsa[k >> 2][k & 3] = (t >= 0) ? r_ : 0.f; } }
#pragma unroll
        for (int ai = 0; ai < 2; ++ai) {
            const int t0 = 248 * jj + 62 * (2 * ai + wr) - 2 + 4 * fr;
            float rs[4];
#pragma unroll
            for (int m = 0; m < 4; ++m) rs[m] = rsa[ai][m];
            u32x2 gp[4];
#pragma unroll
            for (int n = 0; n < 2; ++n) {
                f32x4 av[4];
#pragma unroll
                for (int m = 0; m < 4; ++m) { av[m] = acc[ai][0][m][n] * rs[m];
                    if (ai == 0 && m < 2) { if (t0 + m < 0) av[m] = (f32x4){0.f, 0.f, 0.f, 0.f}; } }
                f32x4 s3, s2;
#pragma unroll
                for (int e = 0; e < 4; ++e) { s3[e] = row_shift0<1>(av[3][e]); s2[e] = row_shift0<1>(av[2][e]); }
#pragma unroll
                for (int m = 0; m < 4; ++m) {
                    const f32x4 a1 = m == 0 ? s3 : av[m == 0 ? 0 : m - 1], a2 = m == 0 ? s2 : m == 1 ? s3 : av[m < 2 ? 0 : m - 2];
                    f32x4 gv;
#pragma unroll
                    for (int e = 0; e < 4; ++e) {
                        const float cv = __builtin_fmaf(w2[n][e], av[m][e], __builtin_fmaf(w1[n][e], a1[e], __builtin_fmaf(w0[n][e], a2[e], bi[n][e])));
                        gv[e] = (cv * __builtin_amdgcn_rcpf(1.0f + fexp2(cv * -LOG2E))) * (acc[ai][1][m][n][e] * rs[m]); }
                    if (n == 0) { gp[m].x = cvt_pk_bf16(gv[0], gv[1]); gp[m].y = cvt_pk_bf16(gv[2], gv[3]); }
                    else { const int t = t0 + m;
                        if ((fr > 0 || m >= 2) && t < SEQ) { u32x4 w; w.x = gp[m].x; w.y = gp[m].y; w.z = cvt_pk_bf16(gv[0], gv[1]); w.w = cvt_pk_bf16(gv[2], gv[3]);
                            *(GAS u32x4*)(G + (size_t)((long)b * SEQ + t) * FF + ch0) = w; } }
                }
            }
        }
    }
};
struct EpiIn {
    static constexpr bool PERM = true;
    static constexpr bool PREFETCH = true;
    __device__ __forceinline__ void prefetch(LAS unsigned char* sp, long arow, const pg8::Unit& u, int wid, int lane_) const {
        int lane; asm volatile("v_mbcnt_lo_u32_b32 %0, -1, 0\n\tv_mbcnt_hi_u32_b32 %0, -1, %0" : "=v"(lane));
#pragma unroll
        for (int i = 0; i < 2; ++i) { const long gr = arow + wid * 32 + 16 * i + (lane >> 2);
            __builtin_amdgcn_global_load_lds((const GAS unsigned*)(ssp + gr * 16 + (lane & 3) * 4), (LAS unsigned*)(sp + wid * 2048 + i * 1024), 16, 0, 0); }
    }
    int kind;
    unsigned char* ws;
    LAS unsigned char* sp_;
    const float* ssp;
    __device__ __forceinline__ void operator()(f32x4 (&acc)[2][2][4][2], const pg8::Unit& u, int wr, int wc, int fr, int fq) const {
        bf16_t* dst; int ld; int mode = 0; const int pn = u.pn;
        if (kind == 0) {
            if (pn < 8) { dst = (bf16_t*)(ws + WS_OA) + pn * 256; ld = LDOA; }
            else if (pn == 8) { dst = (bf16_t*)(ws + WS_QR); ld = 256; mode = 3; }
            else if (pn == 9) { dst = (bf16_t*)(ws + WS_CKV); ld = CKVP; }
            else if (pn == 10) { dst = (bf16_t*)(ws + WS_CKV) + 256; ld = CKVP; mode = 4; }
            else if (pn < 15) { dst = (bf16_t*)(ws + WS_QI) + (pn - 11) * 256; ld = 1024; mode = 2; }
            else { dst = (bf16_t*)(ws + WS_OA) + 2048; ld = LDOA; }
        } else if (kind == 1) {
            if (pn < 4) { dst = (bf16_t*)(ws + WS_OB) + pn * 256; ld = LDOB; mode = 2; }
            else if (pn == 4) { dst = (bf16_t*)(ws + WS_KB); ld = 256; mode = 2; }
            else if (pn == 5) { dst = (bf16_t*)(ws + WS_VB); ld = 256; }
            else { dst = (bf16_t*)(ws + WS_OB) + 1024; ld = LDOB; }
        } else {
            if (pn < 4) { dst = (bf16_t*)(ws + WS_OC) + pn * 256; ld = LDOB; mode = 1; }
            else if (pn < 8) { dst = (bf16_t*)(ws + WS_KC) + (pn - 4) * 256; ld = 1024; mode = 1; }
            else if (pn < 12) { dst = (bf16_t*)(ws + WS_VC) + (pn - 8) * 256; ld = 1024; }
            else { dst = (bf16_t*)(ws + WS_OC) + 1024; ld = LDOB; }
        }
        const int row0 = u.pm * 256 + wr * 64 + fr;
        asm volatile("" ::: "memory");
        { f32x4 pq[8];
          int ln_; asm volatile("v_mbcnt_lo_u32_b32 %0, -1, 0\n\tv_mbcnt_hi_u32_b32 %0, -1, %0" : "=v"(ln_)); const int fr_ = ln_ & 15, fq_ = ln_ >> 4;
#pragma unroll
          for (int k = 0; k < 8; ++k) pq[k] = *(const LAS f32x4*)(sp_ + (wr * 64 + fr_ + (k >> 2) * 128 + (k & 3) * 16) * 64 + fq_ * 16);
          __builtin_amdgcn_sched_barrier(0);
#pragma unroll
          for (int k = 0; k < 8; ++k) { const float rs = rstd_from_q(pq[k]);
#pragma unroll
              for (int bj = 0; bj < 2; ++bj)
#pragma unroll
                  for (int n = 0; n < 2; ++n) acc[k >> 2][bj][k & 3][n] *= rs; } }
        const bool r32 = (mode == 1 && wc == 0) || mode == 3 || (mode == 4 && wc == 0);
        const bool r16 = (mode == 2 && (wc & 1) == 0) || (mode == 4 && wc == 1);
        if (r32 || r16) {
            const int xl = r32 ? 32 : 16;
            const bool second = r32 ? (fq >= 2) : (fq & 1);
            const float* ct = (const float*)(ws + (r32 ? WS_COS32 : WS_COS16)); const float* st = (const float*)(ws + (r32 ? WS_SIN32 : WS_SIN16));
            const int tw = r32 ? 16 : 8, i0 = r32 ? 8 * (fq & 1) : 0;
            const int nbj = (mode == 4) ? 1 : 2;
#define EI_TAB(k_, c0_, c1_, s0_, s1_) do { const int row_ = row0 + ((k_) >> 2) * 128 + ((k_) & 3) * 16; \
                c0_ = *(const GAS f32x4*)(ct + (size_t)row_ * tw + i0); c1_ = *(const GAS f32x4*)(ct + (size_t)row_ * tw + i0 + 4); \
                s0_ = *(const GAS f32x4*)(st + (size_t)row_ * tw + i0); s1_ = *(const GAS f32x4*)(st + (size_t)row_ * tw + i0 + 4); } while (0)
            f32x4 nc0, nc1, ns0, ns1; EI_TAB(0, nc0, nc1, ns0, ns1);
            const bool act = r32 ? true : (fq < 2);
#pragma unroll
            for (int k = 0; k < 8; ++k) {
                const f32x4 c0 = nc0, c1 = nc1, s0 = ns0, s1 = ns1;
                if (k < 7) { EI_TAB(k + 1, nc0, nc1, ns0, ns1); }
                __builtin_amdgcn_sched_barrier(0);
                const int ai = k >> 2, m = k & 3;
#pragma unroll
                for (int bj = 0; bj < 2; ++bj) { if (bj < nbj) {
#pragma unroll
                    for (int n = 0; n < 2; ++n) { f32x4 v = acc[ai][bj][m][n]; const f32x4 cc = n ? c1 : c0, ss = n ? s1 : s0; f32x4 o;
#pragma unroll
                        for (int e = 0; e < 4; ++e) { const float p = __shfl_xor(v[e], xl); o[e] = second ? (v[e] * cc[e] + p * ss[e]) : (v[e] * cc[e] - p * ss[e]); }
                        if (act) acc[ai][bj][m][n] = o; } } }
            }
#undef EI_TAB
        }
        if (mode != 4) {
            const int col0 = wc * 32 + 8 * fq;
#pragma unroll
            for (int ai = 0; ai < 2; ++ai)
#pragma unroll
                for (int m = 0; m < 4; ++m) { bf16_t* rowp = dst + (size_t)(row0 + ai * 128 + m * 16) * ld + col0;
#pragma unroll
                    for (int bj = 0; bj < 2; ++bj) { const f32x4 v0 = acc[ai][bj][m][0], v1 = acc[ai][bj][m][1];
                        u32x4 w; w.x = cvt_pk_bf16(v0[0], v0[1]); w.y = cvt_pk_bf16(v0[2], v0[3]); w.z = cvt_pk_bf16(v1[0], v1[1]); w.w = cvt_pk_bf16(v1[2], v1[3]);
                        *(GAS u32x4*)(rowp + bj * 128) = w; } }
        } else {
            bf16_t* KI = (bf16_t*)(ws + WS_KI); float* WI = (float*)(ws + WS_WI);
#pragma unroll
            for (int ai = 0; ai < 2; ++ai)
#pragma unroll
                for (int m = 0; m < 4; ++m) { const size_t row = (size_t)(row0 + ai * 128 + m * 16); const f32x4 v0 = acc[ai][0][m][0], v1 = acc[ai][0][m][1];
                    u32x4 w; w.x = cvt_pk_bf16(v0[0], v0[1]); w.y = cvt_pk_bf16(v0[2], v0[3]); w.z = cvt_pk_bf16(v1[0], v1[1]); w.w = cvt_pk_bf16(v1[2], v1[3]);
                    if (wc == 0) *(GAS u32x4*)(dst + row * CKVP + 8 * fq) = w;
                    else if (wc < 3) *(GAS u32x4*)(KI + row * 64 + (wc - 1) * 32 + 8 * fq) = w;
                    else if (fq < 2) { *(GAS f32x4*)(WI + row * 16 + 8 * fq) = v0 * 0.03125f; *(GAS f32x4*)(WI + row * 16 + 8 * fq + 4) = v1 * 0.03125f; } }
        }
    }
};

struct Args {
    const float* x; const float* mem; const int* positions;
    const float* g_mix; const float* g_ffn; const float* g_mem; const float* g_final; const float* w_mem_kv;
    const float* a_w_in; const float* a_kv_norm; const float* a_w_uk; const float* a_w_uv; const float* a_w_out;
    const float* b_w_in; const float* b_sinks; const float* b_w_out; const float* c_w_in; const float* c_w_out;
    const float* f_w_up; const float* f_conv_w; const float* f_conv_b; const float* f_w_down;
    float* out; unsigned char* ws;
    int ph_lo, ph_hi;
};

template <class T> __device__ __forceinline__ T* gptr(T* p) { return (T*)(GAS T*)p; }
typedef const __attribute__((address_space(4))) Args* ArgP;
__device__ __forceinline__ ArgP argp() { ArgP p = (ArgP)__builtin_amdgcn_kernarg_segment_ptr(); asm volatile("" : "+s"(p)); return p; }
struct Ctx { LAS unsigned char* lds; int tid, lane, wave, vcu, G, gw, NGW; };
__device__ __forceinline__ int lane_id() { int l; asm volatile("v_mbcnt_lo_u32_b32 %0, -1, 0\n\tv_mbcnt_hi_u32_b32 %0, -1, %0" : "=v"(l)); return l; }
__device__ __forceinline__ Ctx launder(Ctx c) { int l = lane_id(); asm volatile("" : "+v"(l)); c.lane = l; c.tid = c.wave * 64 + l;
    asm volatile("" : "+s"(c.wave), "+s"(c.vcu), "+s"(c.gw)); return c; }

__device__ __forceinline__ void transpose_job(const Ctx& c, int& base, const float* W, int ldw, int k_org, int n_org, int Ksub, int Nsub, bf16_t* WT, int ldt, int koff, const float* gain = nullptr) {
    LAS float* scr = (LAS float*)(c.lds + c.wave * 16384);
    const int nblk = Nsub / 32, nitems = (Ksub / 64) * nblk, lane = c.lane;
    int start = (c.gw - (base % c.NGW) + c.NGW) % c.NGW; base += nitems;
    if (start >= nitems) return;
    const int ch = lane & 7;
    float v[32]; f32x4 g0 = {1.f, 1.f, 1.f, 1.f}, g1 = {1.f, 1.f, 1.f, 1.f};
#define TJ_LOAD(it_) do { const int kb_ = (it_) / nblk, nb_ = (it_) % nblk; const float* wp_ = W + (size_t)(k_org + 64 * kb_ + (lane >> 5)) * ldw + n_org + 32 * nb_ + (lane & 31); \
        _Pragma("unroll") for (int i = 0; i < 32; ++i) v[i] = __builtin_nontemporal_load((const GAS float*)wp_ + (size_t)(2 * i) * ldw); \
        if (gain) { g0 = *(const GAS f32x4*)(gain + k_org + 64 * kb_ + 8 * ch); g1 = *(const GAS f32x4*)(gain + k_org + 64 * kb_ + 8 * ch + 4); } } while (0)
    TJ_LOAD(start);
    for (int it = start; it < nitems; it += c.NGW) {
        const int kb = it / nblk, nb = it % nblk, k0 = 64 * kb, n0 = 32 * nb;
#pragma unroll
        for (int i = 0; i < 32; ++i) scr[(2 * i + (lane >> 5)) * 33 + (lane & 31)] = v[i];
        const f32x4 h0 = g0, h1 = g1;
        asm volatile("s_waitcnt lgkmcnt(0)" ::: "memory");
        if (it + c.NGW < nitems) { TJ_LOAD(it + c.NGW); }
#pragma unroll
        for (int j = 0; j < 4; ++j) { const int n = (lane >> 3) + 8 * j; const LAS float* sp = scr + (8 * ch) * 33 + n;
            u32x4 o; o.x = cvt_pk_bf16(sp[0 * 33] * h0[0], sp[1 * 33] * h0[1]); o.y = cvt_pk_bf16(sp[2 * 33] * h0[2], sp[3 * 33] * h0[3]); o.z = cvt_pk_bf16(sp[4 * 33] * h1[0], sp[5 * 33] * h1[1]); o.w = cvt_pk_bf16(sp[6 * 33] * h1[2], sp[7 * 33] * h1[3]);
            *(GAS u32x4*)(WT + (size_t)(n0 + n) * ldt + koff + k0 + 8 * ch) = o; }
        asm volatile("s_waitcnt lgkmcnt(0)" ::: "memory");
    }
#undef TJ_LOAD
}
__device__ __forceinline__ void rms_row_bf16(const float* xrow, const float* gain, bf16_t* orow, int lane) {
    const f32x4* xr = (const f32x4*)xrow + lane; const f32x4* gr = (const f32x4*)gain + lane;
    f32x4 v[4]; float s = 0.f;
#pragma unroll
    for (int j = 0; j < 4; ++j) { v[j] = xr[64 * j]; s += (v[j].x * v[j].x + v[j].y * v[j].y) + (v[j].z * v[j].z + v[j].w * v[j].w); }
    const float rstd = 1.0f / sqrtf(wave_sum(s) * (1.f / DM) + EPS);
    u32x2* o8 = (u32x2*)orow + lane;
#pragma unroll
    for (int j = 0; j < 4; ++j) { const f32x4 gg = gr[64 * j]; u32x2 w; w.x = cvt_pk_bf16(v[j].x * rstd * gg.x, v[j].y * rstd * gg.y); w.y = cvt_pk_bf16(v[j].z * rstd * gg.z, v[j].w * rstd * gg.w); o8[64 * j] = w; }
}
__device__ __forceinline__ void rms_rows_phase(const Ctx& c0, const float* x, const float* gain, bf16_t* xn, int nrows) {
    const Ctx c = launder(c0);
    for (int m = c.gw; m < nrows; m += c.NGW) rms_row_bf16(x + (size_t)m * DM, gain, xn + (size_t)m * DM, c.lane);
}
__device__ __forceinline__ void final_norm_phase(const Ctx& c0, const bf16_t* xb, const float* ssp, const float* gain, float* out) {
    const Ctx c = launder(c0);
    f32x4 gg[4];
#pragma unroll
    for (int j = 0; j < 4; ++j) gg[j] = ((const GAS f32x4*)gain + c.lane)[64 * j];
    for (int m = c.gw; m < MTOK; m += c.NGW) {
        const GAS u32x2* xr = (const GAS u32x2*)(xb + (size_t)m * DM) + c.lane; f32x4* o = (f32x4*)(out + (size_t)m * DM) + c.lane;
        u32x2 w[4];
#pragma unroll
        for (int j = 0; j < 4; ++j) w[j] = __builtin_nontemporal_load(xr + 64 * j);
        const float rstd = row_rstd(ssp, m);
#pragma unroll
        for (int j = 0; j < 4; ++j) __builtin_nontemporal_store((f32x4){bflo(w[j].x) * rstd * gg[j].x, bfhi(w[j].x) * rstd * gg[j].y, bflo(w[j].y) * rstd * gg[j].z, bfhi(w[j].y) * rstd * gg[j].w}, (GAS f32x4*)(o + 64 * j));
    }
}
__device__ __forceinline__ void prologue1(const Ctx& c0) {
    const Ctx c = launder(c0);
    ArgP ap = argp();
#define a (*ap)
    unsigned char* ws = gptr(a.ws);
    const int gt = c.gw * 64 + c.lane, NGT = c.NGW * 64;
    int base = 0;
#pragma nounroll
    for (int l = 0; l < DEPTH; ++l) {
        const int kind = l % 3, j = l / 3;
        unsigned char* wl = ws + WS_WT + (size_t)l * WT_LAYER;
        const float* gm = gptr(a.g_mix) + (size_t)l * DM; const float* gf = gptr(a.g_ffn) + (size_t)l * DM;
#pragma nounroll
        for (int pn = 0; pn < 22; ++pn) {
            transpose_job(c, base, gptr(a.f_w_up) + (size_t)l * DM * 2 * FF, 2 * FF, 0, 128 * pn, DM, 128, (bf16_t*)(wl + WT_UP) + (size_t)(256 * pn) * DM, DM, 0, gf);
            transpose_job(c, base, gptr(a.f_w_up) + (size_t)l * DM * 2 * FF, 2 * FF, 0, FF + 128 * pn, DM, 128, (bf16_t*)(wl + WT_UP) + (size_t)(256 * pn + 128) * DM, DM, 0, gf);
        }
        transpose_job(c, base, gptr(a.f_w_down) + (size_t)l * FF * DM, DM, 0, 0, FF, DM, (bf16_t*)(wl + WT_DOWN), FF, 0);
        transpose_job(c, base, gptr(a.w_mem_kv) + (size_t)l * DM * 512, 512, 0, 0, DM, 512, (bf16_t*)(wl + WT_MKV), DM, 0);
        if (kind == 1) {
            transpose_job(c, base, gptr(a.b_w_out), DM, 0, 0, 1280, DM, (bf16_t*)(wl + WT_OUT), 1280, 0);
            transpose_job(c, base, gptr(a.b_w_in), NB_IN, 0, 0, DM, NB_IN, (bf16_t*)(wl + WT_IN), DM, 0, gm);
        } else if (kind == 2) {
            transpose_job(c, base, gptr(a.c_w_out), DM, 0, 0, 1280, DM, (bf16_t*)(wl + WT_OUT), 1280, 0);
            transpose_job(c, base, gptr(a.c_w_in), NC_IN, 0, 0, DM, NC_IN, (bf16_t*)(wl + WT_IN), DM, 0, gm);
        } else {
            const float* win = gptr(a.a_w_in) + (size_t)j * DM * 2672; const float* wout = gptr(a.a_w_out) + (size_t)j * 1280 * DM;
            unsigned char* tmp = ws + WS_TMP + (size_t)j * TMP_STRIDE;
            bf16_t* wit = (bf16_t*)(wl + WT_IN);
            transpose_job(c, base, wout, DM, 0, 0, 1280, DM, (bf16_t*)(tmp + TMP_WOT), 1280, 0);
            transpose_job(c, base, wout, DM, 1024, 0, 256, DM, (bf16_t*)(wl + WT_OUT), LDOA, 2048);
#pragma nounroll
            for (int h = 0; h < 8; ++h) transpose_job(c, base, win, 2672, 0, h * 128, DM, 32, wit + (size_t)(2048 + 32 * h) * DM, DM, 0, gm);
            transpose_job(c, base, win, 2672, 0, 1024, DM, 256, wit + (size_t)2304 * DM, DM, 0, gm);
            transpose_job(c, base, win, 2672, 0, 1280, DM, 32, wit + (size_t)2560 * DM, DM, 0, gm);
            transpose_job(c, base, win, 2672, 0, 2336, DM, 96, wit + (size_t)2592 * DM, DM, 0, gm);
            transpose_job(c, base, win, 2672, 0, 1312, DM, 1024, wit + (size_t)2816 * DM, DM, 0, gm);
            transpose_job(c, base, win, 2672, 0, 2416, DM, 256, wit + (size_t)3840 * DM, DM, 0, gm);
            { u32x4* z = (u32x4*)(wit + (size_t)2688 * DM); for (int i = gt; i < 128 * DM / 8; i += NGT) z[i] = (u32x4){0u, 0u, 0u, 0u}; }
            { const GAS f32x4* s = (const GAS f32x4*)win; u32x2* d = (u32x2*)(tmp + TMP_WNAT); constexpr int NQ = DM * 2672 / 4;
              for (int i0 = gt; i0 < NQ; i0 += 3 * NGT) { f32x4 v[3]; float g[3];
#pragma unroll
                  for (int u = 0; u < 3; ++u) { const int i = i0 + u * NGT < NQ ? i0 + u * NGT : i0; v[u] = __builtin_nontemporal_load(s + i); g[u] = ((const GAS float*)gm)[i / 668]; }
#pragma unroll
                  for (int u = 0; u < 3; ++u) { const int i = i0 + u * NGT; if (i < NQ) { const f32x4 q = v[u] * g[u]; u32x2 w; w.x = cvt_pk_bf16(q.x, q.y); w.y = cvt_pk_bf16(q.z, q.w); d[i] = w; } } } }
            { const GAS f32x4* s = (const GAS f32x4*)(gptr(a.a_w_uv) + (size_t)j * 256 * 1024); u32x2* d = (u32x2*)(tmp + TMP_WUVN); constexpr int NQ = 256 * 1024 / 4;
              for (int i0 = gt; i0 < NQ; i0 += 2 * NGT) { f32x4 v[2];
#pragma unroll
                  for (int u = 0; u < 2; ++u) { const int i = i0 + u * NGT < NQ ? i0 + u * NGT : i0; v[u] = __builtin_nontemporal_load(s + i); }
#pragma unroll
                  for (int u = 0; u < 2; ++u) { const int i = i0 + u * NGT; if (i < NQ) { u32x2 w; w.x = cvt_pk_bf16(v[u].x, v[u].y); w.y = cvt_pk_bf16(v[u].z, v[u].w); d[i] = w; } } } }
            { const float* s = gptr(a.a_w_uk) + (size_t)j * 256 * 8 * 96; bf16_t* d = (bf16_t*)(tmp + TMP_WUKT);
              for (int i = gt; i < 8 * 256 * 128; i += NGT) { const int n = i & 127, r = (i >> 7) & 255, h = i >> 15; d[i] = (bf16_t)(n < 96 ? f2bf(s[((size_t)r * 8 + h) * 96 + n]) : 0u); } }
        }
    }
    { float* c32 = (float*)(ws + WS_COS32); float* s32 = (float*)(ws + WS_SIN32); float* c16 = (float*)(ws + WS_COS16); float* s16 = (float*)(ws + WS_SIN16);
      for (int i = gt; i < MTOK * 24; i += NGT) { const int row = i / 24, k = i % 24; const float pos = (float)gptr(a.positions)[row];
          const float ex = (k < 16) ? (float)k * (-1.0f / 16.0f) : (float)(k - 16) * (-1.0f / 8.0f); const float inv = exp2f(ex * 18.931568569324174f); const float ang = pos * inv;
          const double ad = (double)ang; const double kk = rint(ad * 0.15915494309189535); const float r = (float)(ad - kk * 6.283185307179586);
          const float cs = __cosf(r), sn = __sinf(r);
          if (k < 16) { c32[row * 16 + k] = cs; s32[row * 16 + k] = sn; } else { c16[row * 8 + k - 16] = cs; s16[row * 8 + k - 16] = sn; } } }
    rms_rows_phase(c, gptr(a.mem), gptr(a.g_mem), (bf16_t*)(ws + WS_MEMN), BATCH * MEMLEN);
    { bf16_t* xb = (bf16_t*)(ws + WS_XN); float* ssp = (float*)(ws + WS_SSP);
      for (int m0 = c.gw; m0 < MTOK; m0 += 2 * c.NGW) {
          f32x4 v[2][4];
#pragma unroll
          for (int r = 0; r < 2; ++r) { const int m = m0 + r * c.NGW < MTOK ? m0 + r * c.NGW : m0; const GAS f32x4* xr = (const GAS f32x4*)(gptr(a.x) + (size_t)m * DM) + c.lane;
#pragma unroll
              for (int jq = 0; jq < 4; ++jq) v[r][jq] = __builtin_nontemporal_load(xr + 64 * jq); }
          __builtin_amdgcn_sched_barrier(0);
#pragma unroll
          for (int r = 0; r < 2; ++r) { const int m = m0 + r * c.NGW; if (m < MTOK) { u32x2* o8 = (u32x2*)(xb + (size_t)m * DM) + c.lane; float s2 = 0.f;
#pragma unroll
              for (int jq = 0; jq < 4; ++jq) { const f32x4 q = v[r][jq]; s2 += (q.x * q.x + q.y * q.y) + (q.z * q.z + q.w * q.w); u32x2 w; w.x = cvt_pk_bf16(q.x, q.y); w.y = cvt_pk_bf16(q.z, q.w); o8[64 * jq] = w; }
              s2 = wave_sum(s2); if (c.lane < 16) ssp[(size_t)m * 16 + c.lane] = (c.lane == 0) ? s2 : 0.f; } } } }
}

#undef a
__device__ __forceinline__ void prologue2(const Ctx& c0, unsigned char* ws) {
    const Ctx c = launder(c0);
    for (int w = blockIdx.x; w < 192; w += c.G) {
        pg8::Gemm g; pg8::OneUnit S; EpiPlain E; S.have = true; E.O2 = nullptr; E.split = 1 << 30;
        if (w < 128) {
            const int j = w >> 6, r = w & 63; unsigned char* tmp = ws + WS_TMP + (size_t)j * TMP_STRIDE; unsigned char* wl = ws + WS_WT + (size_t)(3 * j) * WT_LAYER;
            if (r < 32) { const int h = r >> 2, pn = r & 3;
                g.A = (const bf16_t*)(tmp + TMP_WUKT) + (size_t)h * 256 * 128; g.lda = 128; g.Bt = (const bf16_t*)(tmp + TMP_WNAT) + h * 128 + 32; g.ldb = 2672; g.K = 128;
                S.pm = 0; S.pn = pn; E.O = (bf16_t*)(wl + WT_IN) + (size_t)h * 256 * DM; E.ldc = DM;
            } else { const int h = (r - 32) >> 2, pm = (r - 32) & 3;
                g.A = (const bf16_t*)(tmp + TMP_WOT) + h * 128; g.lda = 1280; g.Bt = (const bf16_t*)(tmp + TMP_WUVN) + h * 128; g.ldb = 1024; g.K = 128;
                S.pm = pm; S.pn = 0; E.O = (bf16_t*)(wl + WT_OUT) + h * 256; E.ldc = LDOA;
            }
        } else {
            const int l = (w - 128) >> 4, r = (w - 128) & 15;
            g.A = (const bf16_t*)(ws + WS_MEMN); g.lda = DM; g.Bt = (const bf16_t*)(ws + WS_WT + (size_t)l * WT_LAYER + WT_MKV); g.ldb = DM; g.K = DM;
            S.pm = r >> 1; S.pn = r & 1; E.O = (bf16_t*)(ws + WS_KVM + (size_t)l * 2 * MiB); E.ldc = 512;
        }
        pg8::gemm_phase<EpiPlain, pg8::OneUnit>(c.lds, g, S, E, c.wave);
    }
}

template <int D>
__device__ __forceinline__ void wave_attn(const bf16_t* q, long qs, const bf16_t* k, const bf16_t* v, long ks, int t0, int t1, int tq, int W, float sc_l2,
                                          float& m, float& l, f32x16 (&O)[D / 32], LAS unsigned char* vbuf, int lane) {
    constexpr int NS = D / 16, ND = D / 32, VP = D * 2 + 16;
    const int r32 = lane & 31, hi = lane >> 5;
    bf16x8 qf[NS];
#pragma unroll
    for (int s = 0; s < NS; ++s) qf[s] = *(const GAS bf16x8*)(q + (long)r32 * qs + 16 * s + 8 * hi);
    constexpr int LPR = D / 8;
    constexpr int RPI = 64 / LPR;
    bf16x8 kf[NS]; u32x4 tmp[32 / RPI];
#define WA_LOAD(tt_) do { const bf16_t* kt = k + (long)(32 * (tt_) + r32) * ks + 8 * hi; \
        _Pragma("unroll") for (int s = 0; s < NS; ++s) kf[s] = *(const GAS bf16x8*)(kt + 16 * s); \
        const bf16_t* vt = v + (long)(32 * (tt_)) * ks; \
        _Pragma("unroll") for (int i = 0; i < 32 / RPI; ++i) { const int row = i * RPI + lane / LPR; tmp[i] = *(const GAS u32x4*)(vt + (long)row * ks + (lane % LPR) * 8); } } while (0)
    WA_LOAD(t0);
    for (int t = t0; t <= t1; ++t) {
        f32x16 S = {};
        __builtin_amdgcn_s_setprio(1);
#pragma unroll
        for (int s = 0; s < NS; ++s) S = __builtin_amdgcn_mfma_f32_32x32x16_bf16(kf[s], qf[s], S, 0, 0, 0);
        __builtin_amdgcn_s_setprio(0);
        asm volatile("" ::: "memory");
#pragma unroll
        for (int i = 0; i < 32 / RPI; ++i) { const int row = i * RPI + lane / LPR; *(LAS u32x4*)(vbuf + row * VP + (lane % LPR) * 16) = tmp[i]; }
        asm volatile("" ::: "memory");
        if (t < t1) { WA_LOAD(t + 1); }
        float mt = NEGBIG;
        if (W >= 0 && (t == t1 || 32 * (t - tq) - 31 < -W)) {
            const int db = 32 * (t - tq) - r32 + 4 * hi;
#pragma unroll
            for (int r = 0; r < 16; ++r) { const int dl = db + (r & 3) + 8 * (r >> 2); const bool ok = (dl <= 0) && (dl >= -W); S[r] = ok ? S[r] : NEGBIG; mt = fmaxf(mt, S[r]); }
        } else {
#pragma unroll
            for (int r = 0; r < 16; ++r) mt = fmaxf(mt, S[r]);
        }
        mt = xmax32(mt) * sc_l2;
        const float mn = fmaxf(m, mt);
        if (__any(mn > m + 8.0f)) {
            const float al = fexp2(m - mn); l *= al;
#pragma unroll
            for (int d = 0; d < ND; ++d)
#pragma unroll
                for (int r = 0; r < 16; ++r) O[d][r] *= al;
            m = mn;
        }
        float ps = 0.f;
#pragma unroll
        for (int r = 0; r < 16; ++r) { S[r] = fexp2(__builtin_fmaf(S[r], sc_l2, -m)); ps += S[r]; }
        l += ps;
        bf16x8 pf[2];
#pragma unroll
        for (int s2 = 0; s2 < 2; ++s2) { u32x4 w; w.x = cvt_pk_bf16(S[8 * s2 + 0], S[8 * s2 + 1]); w.y = cvt_pk_bf16(S[8 * s2 + 2], S[8 * s2 + 3]); w.z = cvt_pk_bf16(S[8 * s2 + 4], S[8 * s2 + 5]); w.w = cvt_pk_bf16(S[8 * s2 + 6], S[8 * s2 + 7]);
            pf[s2] = __builtin_bit_cast(bf16x8, w); }
        {
            const int blk = (lane >> 4) & 1, qq = (lane & 15) >> 2, pp = lane & 3;
            const LAS unsigned char* vb = vbuf + (4 * hi + qq) * VP + (16 * blk + 4 * pp) * 2;
            __builtin_amdgcn_s_setprio(1);
#pragma unroll
            for (int d = 0; d < ND; ++d)
#pragma unroll
                for (int s2 = 0; s2 < 2; ++s2) {
                    const s16x4 lo = __builtin_amdgcn_ds_read_tr16_b64_v4i16((LAS s16x4*)(vb + (16 * s2) * VP + d * 64));
                    const s16x4 hi4 = __builtin_amdgcn_ds_read_tr16_b64_v4i16((LAS s16x4*)(vb + (16 * s2 + 8) * VP + d * 64));
                    const bf16x8 vf = (bf16x8){lo[0], lo[1], lo[2], lo[3], hi4[0], hi4[1], hi4[2], hi4[3]};
                    O[d] = __builtin_amdgcn_mfma_f32_32x32x16_bf16(vf, pf[s2], O[d], 0, 0, 0);
                }
            __builtin_amdgcn_s_setprio(0);
        }
    }
}
#undef WA_LOAD
template <int D>
__device__ __forceinline__ void wave_attn2(const bf16_t* q, long qs, const bf16_t* k, const bf16_t* v, long ks, int t0, int t1, int tq, int W, float sc_l2,
                                           float (&m)[2], float (&l)[2], f32x16 (&O)[2][D / 32], LAS unsigned char* vbuf, int lane) {
    constexpr int NS = D / 16, ND = D / 32, VP = D * 2 + 16;
    const int r32 = lane & 31, hi = lane >> 5;
    bf16x8 qf[2][NS];
#pragma unroll
    for (int u = 0; u < 2; ++u)
#pragma unroll
        for (int s = 0; s < NS; ++s) qf[u][s] = *(const GAS bf16x8*)(q + (long)(32 * u + r32) * qs + 16 * s + 8 * hi);
    constexpr int LPR = D / 8, RPI = 64 / LPR;
    bf16x8 kf[NS]; u32x4 tmp[32 / RPI];
#define WA_LOAD(tt_) do { const bf16_t* kt = k + (long)(32 * (tt_) + r32) * ks + 8 * hi; \
        _Pragma("unroll") for (int s = 0; s < NS; ++s) kf[s] = *(const GAS bf16x8*)(kt + 16 * s); \
        const bf16_t* vt = v + (long)(32 * (tt_)) * ks; \
        _Pragma("unroll") for (int i = 0; i < 32 / RPI; ++i) { const int row = i * RPI + lane / LPR; tmp[i] = *(const GAS u32x4*)(vt + (long)row * ks + (lane % LPR) * 8); } } while (0)
    WA_LOAD(t0);
    for (int t = t0; t <= t1; ++t) {
        f32x16 S[2];
        bool act[2];
#pragma unroll
        for (int u = 0; u < 2; ++u) { act[u] = (W < 0) || (t <= tq + u && t >= tq + u - 4);
            S[u] = (f32x16){};
            if (act[u]) {
#pragma unroll
                for (int s = 0; s < NS; ++s) S[u] = __builtin_amdgcn_mfma_f32_32x32x16_bf16(kf[s], qf[u][s], S[u], 0, 0, 0); } }
        asm volatile("" ::: "memory");
#pragma unroll
        for (int i = 0; i < 32 / RPI; ++i) { const int row = i * RPI + lane / LPR; *(LAS u32x4*)(vbuf + row * VP + (lane % LPR) * 16) = tmp[i]; }
        asm volatile("" ::: "memory");
        if (t < t1) { WA_LOAD(t + 1); }
        bf16x8 pf[2][2];
#pragma unroll
        for (int u = 0; u < 2; ++u) {
            if (act[u]) {
                float mt = NEGBIG; const int tqu = tq + u;
                if (W >= 0 && (t == tqu || 32 * (t - tqu) - 31 < -W)) {
                    const int db = 32 * (t - tqu) - r32 + 4 * hi;
#pragma unroll
                    for (int r = 0; r < 16; ++r) { const int dl = db + (r & 3) + 8 * (r >> 2); const bool ok = (dl <= 0) && (dl >= -W); S[u][r] = ok ? S[u][r] : NEGBIG; mt = fmaxf(mt, S[u][r]); }
                } else {
#pragma unroll
                    for (int r = 0; r < 16; ++r) mt = fmaxf(mt, S[u][r]);
                }
                mt = xmax32(mt) * sc_l2;
                const float mn = fmaxf(m[u], mt);
                if (__any(mn > m[u] + 8.0f)) {
                    const float al = fexp2(m[u] - mn); l[u] *= al;
#pragma unroll
                    for (int d = 0; d < ND; ++d)
#pragma unroll
                        for (int r = 0; r < 16; ++r) O[u][d][r] *= al;
                    m[u] = mn;
                }
                float ps = 0.f;
#pragma unroll
                for (int r = 0; r < 16; ++r) { S[u][r] = fexp2(__builtin_fmaf(S[u][r], sc_l2, -m[u])); ps += S[u][r]; }
                l[u] += ps;
#pragma unroll
                for (int s2 = 0; s2 < 2; ++s2) { u32x4 w; w.x = cvt_pk_bf16(S[u][8 * s2 + 0], S[u][8 * s2 + 1]); w.y = cvt_pk_bf16(S[u][8 * s2 + 2], S[u][8 * s2 + 3]); w.z = cvt_pk_bf16(S[u][8 * s2 + 4], S[u][8 * s2 + 5]); w.w = cvt_pk_bf16(S[u][8 * s2 + 6], S[u][8 * s2 + 7]);
                    pf[u][s2] = __builtin_bit_cast(bf16x8, w); }
            } else { pf[u][0] = (bf16x8){0, 0, 0, 0, 0, 0, 0, 0}; pf[u][1] = (bf16x8){0, 0, 0, 0, 0, 0, 0, 0}; }
        }
        {
            const int blk = (lane >> 4) & 1, qq = (lane & 15) >> 2, pp = lane & 3;
            const LAS unsigned char* vb = vbuf + (4 * hi + qq) * VP + (16 * blk + 4 * pp) * 2;
            __builtin_amdgcn_s_setprio(1);
#pragma unroll
            for (int d = 0; d < ND; ++d)
#pragma unroll
                for (int s2 = 0; s2 < 2; ++s2) {
                    const s16x4 lo = __builtin_amdgcn_ds_read_tr16_b64_v4i16((LAS s16x4*)(vb + (16 * s2) * VP + d * 64));
                    const s16x4 hi4 = __builtin_amdgcn_ds_read_tr16_b64_v4i16((LAS s16x4*)(vb + (16 * s2 + 8) * VP + d * 64));
                    const bf16x8 vf = (bf16x8){lo[0], lo[1], lo[2], lo[3], hi4[0], hi4[1], hi4[2], hi4[3]};
                    O[0][d] = __builtin_amdgcn_mfma_f32_32x32x16_bf16(vf, pf[0][s2], O[0][d], 0, 0, 0);
                    O[1][d] = __builtin_amdgcn_mfma_f32_32x32x16_bf16(vf, pf[1][s2], O[1][d], 0, 0, 0);
                }
            __builtin_amdgcn_s_setprio(0);
        }
    }
#undef WA_LOAD
}
template <int D>
__device__ __forceinline__ void store_ot(const f32x16 (&O)[D / 32], float inv_l, bf16_t* out, long os, int lane) {
    const int r32 = lane & 31, hi = lane >> 5;
#pragma unroll
    for (int d = 0; d < D / 32; ++d)
#pragma unroll
        for (int g = 0; g < 4; ++g) { u32x2 w; w.x = cvt_pk_bf16(O[d][4 * g] * inv_l, O[d][4 * g + 1] * inv_l); w.y = cvt_pk_bf16(O[d][4 * g + 2] * inv_l, O[d][4 * g + 3] * inv_l);
            *(GAS u32x2*)(out + (long)r32 * os + 32 * d + 8 * g + 4 * hi) = w; }
}

template <int D>
__device__ __forceinline__ void stage_ot(const f32x16 (&O)[D / 32], float sc, LAS unsigned char* stg, int lane) {
    constexpr int VP = D * 2 + 16; const int r32 = lane & 31, hi = lane >> 5;
    asm volatile("" ::: "memory");
#pragma unroll
    for (int d = 0; d < D / 32; ++d)
#pragma unroll
        for (int g = 0; g < 4; ++g) { u32x2 w; w.x = cvt_pk_bf16(O[d][4 * g] * sc, O[d][4 * g + 1] * sc); w.y = cvt_pk_bf16(O[d][4 * g + 2] * sc, O[d][4 * g + 3] * sc);
            *(LAS u32x2*)(stg + r32 * VP + (32 * d + 8 * g + 4 * hi) * 2) = w; }
    asm volatile("" ::: "memory");
}
template <int D>
__device__ __forceinline__ void store_staged(const LAS unsigned char* stg, bf16_t* out, long os, int lane) {
    constexpr int VP = D * 2 + 16, LPR = D / 8, RPI = 64 / LPR;
#pragma unroll
    for (int i = 0; i < 32 / RPI; ++i) { const int row = i * RPI + lane / LPR; const u32x4 v = *(const LAS u32x4*)(stg + row * VP + (lane % LPR) * 16); *(GAS u32x4*)(out + (long)row * os + (lane % LPR) * 8) = v; }
    asm volatile("" ::: "memory");
}

__device__ __forceinline__ void mem_attn_units(const Ctx& c0, bf16_t* Obase, int ldo, int coloff, const bf16_t* kvm) {
    const Ctx c = launder(c0);
    LAS unsigned char* vbuf = c.lds + c.wave * 8704;
    for (int u = c.gw; u < 2048; u += c.NGW) {
        const int qt = u & 63, h = (u >> 6) & 3, b = u >> 8;
        bf16_t* q = Obase + (size_t)(b * SEQ + 64 * qt) * ldo + coloff + h * 64;
        const bf16_t* k = kvm + (size_t)(b * MEMLEN) * 512 + h * 64;
        float m[2] = {NEGBIG, NEGBIG}, l[2] = {0.f, 0.f}; f32x16 O[2][2] = {};
        wave_attn2<64>(q, ldo, k, k + 256, 512, 0, 7, 0, -1, 0.125f * LOG2E, m, l, O, vbuf, c.lane);
#pragma unroll
        for (int s = 0; s < 2; ++s) { const float ls = xsum32(l[s]);
            stage_ot<64>(O[s], 1.0f / ls, vbuf, c.lane); store_staged<64>(vbuf, q + (size_t)(32 * s) * ldo, ldo, c.lane); }
    }
}

__device__ __forceinline__ void mem_attn_lds(const Ctx& c0, bf16_t* Obase, int ldo, int coloff, const bf16_t* kvm) {
    const Ctx c = launder(c0);
    constexpr int VP = 144;
    LAS unsigned char* vbuf = c.lds + c.wave * 8704;
    LAS unsigned char* Kl = c.lds + 8 * 8704; LAS unsigned char* Vl = Kl + 256 * VP;
    const float sc_l2 = 0.125f * LOG2E;
    for (int ug = c.vcu; ug < 256; ug += c.G) {
        const int lane = lane_id(), r32 = lane & 31, hi = lane >> 5;
        const int h = (ug >> 3) & 3, b = ug >> 5, qt = (ug & 7) * 8 + c.wave;
        __syncthreads();
        { const bf16_t* kg = kvm + (size_t)(b * MEMLEN) * 512 + h * 64; const int tid = c.wave * 64 + lane, row = tid >> 3, ch = tid & 7;
          u32x4 kt[4], vt[4];
#pragma unroll
          for (int p = 0; p < 4; ++p) { kt[p] = *(const GAS u32x4*)(kg + (size_t)(64 * p + row) * 512 + ch * 8); vt[p] = *(const GAS u32x4*)(kg + (size_t)(64 * p + row) * 512 + 256 + ch * 8); }
#pragma unroll
          for (int p = 0; p < 4; ++p) { *(LAS u32x4*)(Kl + (64 * p + row) * VP + ch * 16) = kt[p]; *(LAS u32x4*)(Vl + (64 * p + row) * VP + ch * 16) = vt[p]; } }
        bf16_t* q = Obase + (size_t)(b * SEQ + 64 * qt) * ldo + coloff + h * 64;
        bf16x8 qf[2][4];
#pragma unroll
        for (int u = 0; u < 2; ++u)
#pragma unroll
            for (int s = 0; s < 4; ++s) qf[u][s] = *(const GAS bf16x8*)(q + (long)(32 * u + r32) * ldo + 16 * s + 8 * hi);
        __syncthreads();
        float m[2] = {NEGBIG, NEGBIG}, l[2] = {0.f, 0.f}; f32x16 O[2][2] = {};
        for (int t = 0; t < 8; ++t) {
            f32x16 S[2];
            __builtin_amdgcn_s_setprio(1);
#pragma unroll
            for (int u = 0; u < 2; ++u) { S[u] = (f32x16){};
#pragma unroll
                for (int s = 0; s < 4; ++s) { const bf16x8 kf = *(const LAS bf16x8*)(Kl + (32 * t + r32) * VP + (16 * s + 8 * hi) * 2); S[u] = __builtin_amdgcn_mfma_f32_32x32x16_bf16(kf, qf[u][s], S[u], 0, 0, 0); } }
            __builtin_amdgcn_s_setprio(0);
            bf16x8 pf[2][2];
#pragma unroll
            for (int u = 0; u < 2; ++u) {
                float mt = NEGBIG;
#pragma unroll
                for (int r = 0; r < 16; ++r) mt = fmaxf(mt, S[u][r]);
                mt = xmax32(mt) * sc_l2;
                const float mn = fmaxf(m[u], mt);
                if (__any(mn > m[u] + 8.0f)) {
                    const float al = fexp2(m[u] - mn); l[u] *= al;
#pragma unroll
                    for (int d = 0; d < 2; ++d)
#pragma unroll
                        for (int r = 0; r < 16; ++r) O[u][d][r] *= al;
                    m[u] = mn;
                }
                float ps = 0.f;
#pragma unroll
                for (int r = 0; r < 16; ++r) { S[u][r] = fexp2(__builtin_fmaf(S[u][r], sc_l2, -m[u])); ps += S[u][r]; }
                l[u] += ps;
#pragma unroll
                for (int s2 = 0; s2 < 2; ++s2) { u32x4 w; w.x = cvt_pk_bf16(S[u][8 * s2 + 0], S[u][8 * s2 + 1]); w.y = cvt_pk_bf16(S[u][8 * s2 + 2], S[u][8 * s2 + 3]); w.z = cvt_pk_bf16(S[u][8 * s2 + 4], S[u][8 * s2 + 5]); w.w = cvt_pk_bf16(S[u][8 * s2 + 6], S[u][8 * s2 + 7]);
                    pf[u][s2] = __builtin_bit_cast(bf16x8, w); }
            }
            {
                const int blk = (lane >> 4) & 1, qq = (lane & 15) >> 2, pp = lane & 3;
                const LAS unsigned char* vb = Vl + (32 * t + 4 * hi + qq) * VP + (16 * blk + 4 * pp) * 2;
                __builtin_amdgcn_s_setprio(1);
#pragma unroll
                for (int d = 0; d < 2; ++d)
#pragma unroll
                    for (int s2 = 0; s2 < 2; ++s2) {
                        const s16x4 lo = __builtin_amdgcn_ds_read_tr16_b64_v4i16((LAS s16x4*)(vb + (16 * s2) * VP + d * 64));
                        const s16x4 hi4 = __builtin_amdgcn_ds_read_tr16_b64_v4i16((LAS s16x4*)(vb + (16 * s2 + 8) * VP + d * 64));
                        const bf16x8 vf = (bf16x8){lo[0], lo[1], lo[2], lo[3], hi4[0], hi4[1], hi4[2], hi4[3]};
                        O[0][d] = __builtin_amdgcn_mfma_f32_32x32x16_bf16(vf, pf[0][s2], O[0][d], 0, 0, 0);
                        O[1][d] = __builtin_amdgcn_mfma_f32_32x32x16_bf16(vf, pf[1][s2], O[1][d], 0, 0, 0);
                    }
                __builtin_amdgcn_s_setprio(0);
            }
        }
#pragma unroll
        for (int s = 0; s < 2; ++s) { const float ls = xsum32(l[s]);
            stage_ot<64>(O[s], 1.0f / ls, vbuf, lane); store_staged<64>(vbuf, q + (size_t)(32 * s) * ldo, ldo, lane); }
    }
    __syncthreads();
}

__device__ __forceinline__ void swa_units(const Ctx& c0, unsigned char* ws, const float* sinks) {
    const Ctx c = launder(c0);
    LAS unsigned char* vbuf = c.lds + c.wave * 8704;
    bf16_t* OB = (bf16_t*)(ws + WS_OB); const bf16_t* KB = (const bf16_t*)(ws + WS_KB); const bf16_t* VB = (const bf16_t*)(ws + WS_VB);
    for (int u = c.gw; u < 8192; u += c.NGW) {
        const int qt2 = u & 63, h = (u >> 6) & 15, b = u >> 10, kvh = h >> 2, qt = 2 * qt2;
        bf16_t* q = OB + (size_t)(b * SEQ + 32 * qt) * LDOB + h * 64;
        const bf16_t* k = KB + (size_t)(b * SEQ) * 256 + kvh * 64; const bf16_t* v = VB + (size_t)(b * SEQ) * 256 + kvh * 64;
        const float sk = ((const GAS float*)sinks)[h] * LOG2E, l0 = (c.lane < 32) ? 1.f : 0.f;
        float m[2] = {sk, sk}, l[2] = {l0, l0}; f32x16 O[2][2] = {};
        const int t0 = qt - 4 < 0 ? 0 : qt - 4;
        wave_attn2<64>(q, LDOB, k, v, 256, t0, qt + 1, qt, 127, 0.125f * LOG2E, m, l, O, vbuf, c.lane);
#pragma unroll
        for (int s = 0; s < 2; ++s) { const float ls = xsum32(l[s]);
            stage_ot<64>(O[s], 1.0f / ls, vbuf, c.lane); store_staged<64>(vbuf, q + (size_t)(32 * s) * LDOB, LDOB, c.lane); }
    }
}

__device__ __forceinline__ void dil_units(const Ctx& c0, unsigned char* ws, bf16_t* p1buf, int br_lo, int br_hi) {
    const Ctx c = launder(c0);
    LAS unsigned char* vbuf = c.lds + c.wave * 8704;
    bf16_t* OC = (bf16_t*)(ws + WS_OC); const bf16_t* KC = (const bf16_t*)(ws + WS_KC); const bf16_t* VC = (const bf16_t*)(ws + WS_VC);
    GAS float* LSE = (GAS float*)(ws + WS_LSE);
    const int nun = (br_hi - br_lo) * 8192;
    const float sc = 0.08838834764831845f * LOG2E;
    for (int uu = c.gw; uu < nun; uu += c.NGW) {
        const int br = br_lo + (uu >> 13), u = uu & 8191;
        const int dsh = 2 * br, d = 1 << dsh, tps = 128 >> dsh;
        const int bh = u >> 7, b = bh >> 3, h = bh & 7, rho = (u & 127) / tps, tq = (u & 127) % tps;
        const size_t tok0 = (size_t)b * SEQ + rho;
        bf16_t* q = OC + (tok0 + (size_t)d * 32 * tq) * LDOB + h * 128;
        const bf16_t* k = KC + tok0 * 1024 + h * 128; const bf16_t* v = VC + tok0 * 1024 + h * 128;
        float m = NEGBIG, l = 0.f; f32x16 O[4] = {};
        const int t0 = tq - 4 < 0 ? 0 : tq - 4;
        float l0 = 0.f, l1 = 0.f;
        if (br == 2) { const size_t tk = tok0 + (size_t)d * (32 * tq + (c.lane & 31)); l0 = LSE[tk * 8 + h]; l1 = LSE[(size_t)MTOK * 8 + tk * 8 + h]; }
        wave_attn<128>(q, (long)d * LDOB, k, v, (long)d * 1024, t0, tq, tq, 128, sc, m, l, O, vbuf, c.lane);
        l = xsum32(l);
        const float inv_l = 1.0f / l, lse = m + __log2f(l);
        int tq_ = tq, rho_ = rho; asm volatile("" : "+s"(tq_), "+s"(rho_));
        const int ln = lane_id(), r32 = ln & 31, hi = ln >> 5;
        const size_t tok0b = (size_t)b * SEQ + rho_;
        const size_t tok = tok0b + (size_t)d * (32 * tq_ + r32);
        if (br < 2) {
            bf16_t* P = (br == 0) ? p1buf : (bf16_t*)(ws + WS_P2);
            stage_ot<128>(O, inv_l, vbuf, ln); store_staged<128>(vbuf, P + (tok0b + (size_t)d * 32 * tq_) * 1024 + h * 128, (long)d * 1024, ln);
            if (hi == 0) LSE[(size_t)br * MTOK * 8 + tok * 8 + h] = lse;
        } else {
            const float mx = fmaxf(fmaxf(l0, l1), lse);
            float w0 = fexp2(l0 - mx), w1 = fexp2(l1 - mx), w2 = fexp2(lse - mx); const float ws_ = 1.0f / (w0 + w1 + w2); w0 *= ws_; w1 *= ws_; w2 *= ws_ * inv_l;
            stage_ot<128>(O, w2, vbuf, ln);
            if (hi == 0) *(LAS f32x2*)(vbuf + r32 * 272 + 256) = (f32x2){w0, w1};
            asm volatile("" ::: "memory");
            const size_t tokq0 = tok0b + (size_t)d * 32 * tq_;
            u32x4 a1[8], a2[8];
#pragma unroll
            for (int i = 0; i < 8; ++i) { const int row = i * 4 + (ln >> 4), chv = ln & 15; const size_t tr = tokq0 + (size_t)d * row;
                a1[i] = __builtin_nontemporal_load((const GAS u32x4*)((const bf16_t*)p1buf + tr * 1024 + h * 128 + chv * 8)); a2[i] = __builtin_nontemporal_load((const GAS u32x4*)((const bf16_t*)(ws + WS_P2) + tr * 1024 + h * 128 + chv * 8)); }
            __builtin_amdgcn_sched_barrier(0);
#pragma unroll
            for (int i = 0; i < 8; ++i) { const int row = i * 4 + (ln >> 4), chv = ln & 15; const size_t tr = tokq0 + (size_t)d * row;
                const u32x4 a3 = *(const LAS u32x4*)(vbuf + row * 272 + chv * 16); const f32x2 ww = *(const LAS f32x2*)(vbuf + row * 272 + 256);
                u32x4 w;
#pragma unroll
                for (int e = 0; e < 4; ++e) w[e] = cvt_pk_bf16(ww.x * bflo(a1[i][e]) + ww.y * bflo(a2[i][e]) + bflo(a3[e]), ww.x * bfhi(a1[i][e]) + ww.y * bfhi(a2[i][e]) + bfhi(a3[e]));
                *(GAS u32x4*)(OC + tr * LDOB + h * 128 + chv * 8) = w; }
            asm volatile("" ::: "memory");
        }
    }
}

__device__ __forceinline__ void ckv_norm_rows(const Ctx& c0, unsigned char* ws, const float* gain) {
    const Ctx c = launder(c0);
    bf16_t* CKV = (bf16_t*)(ws + WS_CKV);
    const f32x4 g = *((const f32x4*)gain + c.lane);
    for (int m0 = c.gw; m0 < MTOK; m0 += 4 * c.NGW) {
        u32x2 w[4];
#pragma unroll
        for (int j = 0; j < 4; ++j) { const int m = m0 + j * c.NGW; w[j] = *((const GAS u32x2*)(CKV + (size_t)(m < MTOK ? m : MTOK - 1) * CKVP) + c.lane); }
#pragma unroll
        for (int j = 0; j < 4; ++j) { const int m = m0 + j * c.NGW;
            const float v0 = bflo(w[j].x), v1 = bfhi(w[j].x), v2 = bflo(w[j].y), v3 = bfhi(w[j].y);
            const float rstd = __builtin_amdgcn_rsqf(wave_sum(v0 * v0 + v1 * v1 + v2 * v2 + v3 * v3) * (1.f / 256.f) + EPS);
            u32x2 o; o.x = cvt_pk_bf16(v0 * rstd * g.x, v1 * rstd * g.y); o.y = cvt_pk_bf16(v2 * rstd * g.z, v3 * rstd * g.w);
            if (m < MTOK) *((GAS u32x2*)(CKV + (size_t)m * CKVP) + c.lane) = o; }
    }
}
__device__ __forceinline__ void hist_select(const LAS unsigned* hist, int K, int lane, int& bin, int& above, int& inbin) {
    const u32x4 hc = *(const LAS u32x4*)(hist + 4 * lane);
    const int tot = (int)(hc.x + hc.y + hc.z + hc.w);
    int pre = tot;
#define HS_DPP(v_, ctl_, rm_) __builtin_amdgcn_update_dpp(0, (v_), (ctl_), (rm_), 0xf, true)
    pre += HS_DPP(pre, 0x111, 0xf); pre += HS_DPP(pre, 0x112, 0xf); pre += HS_DPP(pre, 0x114, 0xf); pre += HS_DPP(pre, 0x118, 0xf);
    pre += HS_DPP(pre, 0x142, 0xa);
    pre += HS_DPP(pre, 0x143, 0xc);
#undef HS_DPP
    const int all = __builtin_amdgcn_readlane(pre, 63);
    const int suf = all - pre + tot;
    const unsigned long long bal = __ballot(suf >= K);
    const int L = __builtin_amdgcn_readfirstlane(63 - __builtin_clzll(bal | 1ull));
    const int sufL = __builtin_amdgcn_readlane(suf, L), totL = __builtin_amdgcn_readlane(tot, L);
    const int c3 = __builtin_amdgcn_readlane((int)hc.w, L), c2 = __builtin_amdgcn_readlane((int)hc.z, L), c1 = __builtin_amdgcn_readlane((int)hc.y, L), c0 = __builtin_amdgcn_readlane((int)hc.x, L);
    int ab = sufL - totL;
    if (ab + c3 >= K) { bin = 4 * L + 3; above = ab; inbin = c3; return; } ab += c3;
    if (ab + c2 >= K) { bin = 4 * L + 2; above = ab; inbin = c2; return; } ab += c2;
    if (ab + c1 >= K) { bin = 4 * L + 1; above = ab; inbin = c1; return; } ab += c1;
    bin = 4 * L; above = ab; inbin = c0;
}
__device__ __forceinline__ int f2ord(float f) { const int b = __builtin_bit_cast(int, f); return b >= 0 ? b : (b ^ 0x7fffffff); }
__device__ __forceinline__ float ord2f(int o) { return __builtin_bit_cast(float, o >= 0 ? o : (o ^ 0x7fffffff)); }
constexpr int IX_CMAX = 128;
#define IX_KEY(v_) ({ int k_ = (int)(((v_) - mn) * scale); k_ > 65535 ? 65535 : (k_ < 0 ? 0 : k_); })
__device__ __forceinline__ void select_token(const LAS float* row, LAS unsigned* hist, LAS unsigned* cand, int n, float mn, float mx, unsigned short* out_, int lane) {
    GAS unsigned short* out = (GAS unsigned short*)out_;
    if (n <= 256) {
#pragma unroll
        for (int i = 0; i < 4; ++i) { const int j = lane + 64 * i; out[j] = (unsigned short)(j < n ? j : 0); }
        return;
    }
    const float scale = (mx > mn) ? 65535.0f / (mx - mn) : 0.f;
    LAS unsigned short* stg = (LAS unsigned short*)hist;
#define IX_FLUSH() do { asm volatile("" ::: "memory"); const u32x2 fv_ = *(const LAS u32x2*)(hist + 2 * lane); *(GAS u32x2*)(out + 4 * lane) = fv_; asm volatile("" ::: "memory"); } while (0)
    { unsigned z = 0u; asm volatile("" : "+v"(z)); *(LAS u32x4*)(hist + 4 * lane) = (u32x4){z, z, z, z}; }
    for (int j0 = lane; j0 < n; j0 += 512) {
        float v[8];
#pragma unroll
        for (int k = 0; k < 8; ++k) { const int j = j0 + 64 * k; v[k] = (j < n) ? row[j] : mn; }
#pragma unroll
        for (int k = 0; k < 8; ++k) { const int j = j0 + 64 * k; const int key = IX_KEY(v[k]);
            if (j < n) __hip_atomic_fetch_add(hist + (key >> 8), 1u, __ATOMIC_RELAXED, __HIP_MEMORY_SCOPE_WORKGROUP); }
    }
    int b1, ab1, in1; hist_select(hist, 256, lane, b1, ab1, in1);
    const int K2 = 256 - ab1;
    if (in1 <= IX_CMAX) {
        int base = 0, cb = 0;
        for (int j0 = lane; j0 < n; j0 += 512) {
            float v[8];
#pragma unroll
            for (int k = 0; k < 8; ++k) { const int j = j0 + 64 * k; v[k] = (j < n) ? row[j] : mn; }
#pragma unroll
            for (int k = 0; k < 8; ++k) {
                const int j = j0 + 64 * k; const int key = IX_KEY(v[k]); const int bin = (j < n) ? (key >> 8) : -1;
                const bool gt = bin > b1, eq = bin == b1;
                const unsigned long long bg = __ballot(gt), be = __ballot(eq);
                const int pg = base + (int)__builtin_amdgcn_mbcnt_hi((unsigned)(bg >> 32), __builtin_amdgcn_mbcnt_lo((unsigned)bg, 0u));
                const int pe = cb + (int)__builtin_amdgcn_mbcnt_hi((unsigned)(be >> 32), __builtin_amdgcn_mbcnt_lo((unsigned)be, 0u));
                if (gt && pg < 256) stg[pg] = (unsigned short)j;
                if (eq && pe < IX_CMAX) cand[pe] = ((unsigned)(key & 255) << 16) | (unsigned)(0xFFFF - j);
                base += __builtin_popcountll(bg); cb += __builtin_popcountll(be);
            }
        }
#pragma unroll
        for (int h = 0; h < IX_CMAX / 64; ++h) { const int i = lane + 64 * h;
            if (i < in1) { const unsigned me = cand[i]; int rank = 0; for (int c2 = 0; c2 < in1; ++c2) rank += (cand[c2] > me) ? 1 : 0;
                if (rank < K2) stg[ab1 + rank] = (unsigned short)(0xFFFF - (me & 0xFFFFu)); } }
        IX_FLUSH();
        return;
    }
    { unsigned z = 0u; asm volatile("" : "+v"(z)); *(LAS u32x4*)(hist + 4 * lane) = (u32x4){z, z, z, z}; }
    for (int j0 = lane; j0 < n; j0 += 64) { const int key = IX_KEY(row[j0]); if ((key >> 8) == b1) __hip_atomic_fetch_add(hist + (key & 255), 1u, __ATOMIC_RELAXED, __HIP_MEMORY_SCOPE_WORKGROUP); }
    int b2, ab2, in2; hist_select(hist, K2, lane, b2, ab2, in2);
    const int T = (b1 << 8) | b2, krem = K2 - ab2;
    int base = 0, eqb = 0;
    for (int j0 = 0; j0 < n; j0 += 64) {
        const int j = j0 + lane; const int key = (j < n) ? IX_KEY(row[j]) : -1;
        const bool gt = key > T, eq = key == T;
        const unsigned long long beq = __ballot(eq);
        const int rk = eqb + (int)__builtin_amdgcn_mbcnt_hi((unsigned)(beq >> 32), __builtin_amdgcn_mbcnt_lo((unsigned)beq, 0u));
        const bool sel = gt || (eq && rk < krem);
        const unsigned long long bs = __ballot(sel);
        const int pos = base + (int)__builtin_amdgcn_mbcnt_hi((unsigned)(bs >> 32), __builtin_amdgcn_mbcnt_lo((unsigned)bs, 0u));
        if (sel && pos < 256) stg[pos] = (unsigned short)j;
        base += __builtin_popcountll(bs); eqb += __builtin_popcountll(beq);
    }
    IX_FLUSH();
}
#undef IX_FLUSH
#undef IX_KEY
constexpr int IDX_ROWW = 4224;
__device__ __forceinline__ void indexer_load_q(bf16x8 (&af)[4][4], const bf16_t* QI, size_t tokb, int t0) {
    const int lane = lane_id(), r32 = lane & 31, hi = lane >> 5, tk = (r32 >> 2) & 1, hd = (r32 & 3) + 4 * (r32 >> 3);
#pragma unroll
    for (int p = 0; p < 4; ++p) { const bf16_t* qrow = QI + (tokb + t0 + 2 * p + tk) * 1024 + hd * 64 + 8 * hi;
#pragma unroll
        for (int s = 0; s < 4; ++s) af[p][s] = *(const GAS bf16x8*)(qrow + 16 * s); }
}
__device__ __forceinline__ void indexer_scores(const bf16x8 (&af)[4][4], const bf16_t* KI, const float* WI, size_t tokb, int t0, int ntile, int rot, LAS float* sc, int coff, float (&lo_out)[4], float (&hi_out)[4], LAS f32x4* WVL, int w) {
    const int lane = lane_id();
    const int r32 = lane & 31, hi = lane >> 5;
    float lo4[4], hi4[4];
#pragma unroll
    for (int p = 0; p < 4; ++p) { lo4[p] = 3.0e38f; hi4[p] = -3.0e38f; }
    const f32x4 wv_ = *((const GAS f32x4*)(WI + (tokb + t0 + ((lane & 31) >> 2)) * 16) + (lane & 3));
    bf16x8 k0[4], k1[4], k2[4];
#define IXS_LOAD(dst_, tile_) do { const bf16_t* krow = KI + (tokb + 32 * (tile_) + r32) * 64 + 8 * hi; _Pragma("unroll") for (int s = 0; s < 4; ++s) dst_[s] = *(const GAS bf16x8*)(krow + 16 * s); } while (0)
#define IXS_COMP(kf_, tile_) do { f32x16 acc0 = {}, acc1 = {}, acc2 = {}, acc3 = {};                    \
        _Pragma("unroll") for (int s = 0; s < 4; ++s) { acc0 = __builtin_amdgcn_mfma_f32_32x32x16_bf16(af[0][s], kf_[s], acc0, 0, 0, 0); acc1 = __builtin_amdgcn_mfma_f32_32x32x16_bf16(af[1][s], kf_[s], acc1, 0, 0, 0); \
            acc2 = __builtin_amdgcn_mfma_f32_32x32x16_bf16(af[2][s], kf_[s], acc2, 0, 0, 0); acc3 = __builtin_amdgcn_mfma_f32_32x32x16_bf16(af[3][s], kf_[s], acc3, 0, 0, 0); } \
        IXS_RED(0, acc0, tile_); IXS_RED(1, acc1, tile_); IXS_RED(2, acc2, tile_); IXS_RED(3, acc3, tile_); } while (0)
#define IXS_RED(p, acc, tile_) do { float s0 = 0.f, s1 = 0.f; \
            _Pragma("unroll") for (int r4 = 0; r4 < 4; ++r4) { const f32x4 wq = WVL[(2 * (p) + hi) * 4 + r4]; \
                s0 += wq[0] * __builtin_amdgcn_fmed3f(acc[4 * r4], 0.f, 3.0e38f); s1 += wq[1] * __builtin_amdgcn_fmed3f(acc[4 * r4 + 1], 0.f, 3.0e38f); s0 += wq[2] * __builtin_amdgcn_fmed3f(acc[4 * r4 + 2], 0.f, 3.0e38f); s1 += wq[3] * __builtin_amdgcn_fmed3f(acc[4 * r4 + 3], 0.f, 3.0e38f); } \
            const float sv = s0 + s1; sc[(2 * (p) + hi) * IDX_ROWW + coff + 32 * (tile_) + r32] = sv; lo4[p] = fminf(lo4[p], sv); hi4[p] = fmaxf(hi4[p], sv); } while (0)
    int tile = (w - rot) & 7;
    const int tlast = ntile - 1;
#define IXS_CL(t_) ((t_) < tlast ? (t_) : tlast)
    IXS_LOAD(k0, IXS_CL(tile)); IXS_LOAD(k1, IXS_CL(tile + 8)); IXS_LOAD(k2, IXS_CL(tile + 16));
    if (lane < 32) WVL[lane] = wv_;
    for (; tile < ntile; tile += 24) {
        IXS_COMP(k0, tile); IXS_LOAD(k0, IXS_CL(tile + 24));
        if (tile + 8 < ntile) IXS_COMP(k1, tile + 8);
        IXS_LOAD(k1, IXS_CL(tile + 32));
        if (tile + 16 < ntile) IXS_COMP(k2, tile + 16);
        IXS_LOAD(k2, IXS_CL(tile + 40));
    }
#undef IXS_CL
#undef IXS_LOAD
#undef IXS_COMP
#undef IXS_RED
#pragma unroll
    for (int p = 0; p < 4; ++p) { lo_out[p] = lo4[p]; hi_out[p] = hi4[p]; }
}
__device__ __forceinline__ void indexer_minmax(const float (&lo4)[4], const float (&hi4)[4], LAS int* mm) {
    const int lane = lane_id(), r32 = lane & 31, hi = lane >> 5;
#pragma unroll
    for (int p = 0; p < 4; ++p) { const float lo = half_min(lo4[p]), hx = half_max(hi4[p]);
        if (r32 == 0) { __hip_atomic_fetch_min(mm + 2 * (2 * p + hi), f2ord(lo), __ATOMIC_RELAXED, __HIP_MEMORY_SCOPE_WORKGROUP);
                        __hip_atomic_fetch_max(mm + 2 * (2 * p + hi) + 1, f2ord(hx), __ATOMIC_RELAXED, __HIP_MEMORY_SCOPE_WORKGROUP); } }
}
__device__ __forceinline__ void indexer_phase(const Ctx& c0, unsigned char* ws) {
    const Ctx c = launder(c0);
    const bf16_t* QI = (const bf16_t*)(ws + WS_QI); const bf16_t* KI = (const bf16_t*)(ws + WS_KI); const float* WI = (const float*)(ws + WS_WI);
    unsigned short* IDX = (unsigned short*)(ws + WS_IDX);
    LAS float* sc = (LAS float*)c.lds;
    LAS unsigned* hist = (LAS unsigned*)(c.lds + 8 * IDX_ROWW * 4) + c.wave * 256;
    LAS int* mm = (LAS int*)(c.lds + 8 * IDX_ROWW * 4 + 8 * 1024);
    LAS f32x4* WVL = (LAS f32x4*)(c.lds + 8 * IDX_ROWW * 4 + 8 * 1024 + 256 + c.wave * 512);
    LAS unsigned* cand = (LAS unsigned*)(c.lds + 8 * IDX_ROWW * 4 + 8 * 1024 + 256 + 4096 + c.wave * (IX_CMAX * 4));
    const int lane = c.lane, w = c.wave;
    if (c.tid < 32) mm[c.tid] = (c.tid & 1) ? (int)0x80000001 : 0x7fffffff;
    __syncthreads();
    bf16x8 afA[4][4];
    { const int P0 = c.vcu < 2048 ? c.vcu : 0; indexer_load_q(afA, QI, (size_t)(P0 >> 8) * SEQ, 8 * (P0 & 255)); }
    for (int P = c.vcu; P < 2048; P += c.G) {
        const int b = P >> 8, up = P & 255;
        const int tA = 8 * up, tB = 8 * (511 - up), ntA = (tA + 8 + 31) >> 5, ntB = (tB + 8 + 31) >> 5, offB = 32 * ntA;
        const size_t tokb = (size_t)b * SEQ;
        float loA[4], hiA[4], loB[4], hiB[4];
        indexer_scores(afA, KI, WI, tokb, tA, ntA, 0, sc, 0, loA, hiA, WVL, w);
        { bf16x8 afB[4][4]; indexer_load_q(afB, QI, tokb, tB);
          indexer_minmax(loA, hiA, mm);
          indexer_scores(afB, KI, WI, tokb, tB, ntB, ntA & 7, sc, offB, loB, hiB, WVL, w); }
        { const int Pn = (P + c.G < 2048) ? P + c.G : P; indexer_load_q(afA, QI, (size_t)(Pn >> 8) * SEQ, 8 * (Pn & 255)); }
        indexer_minmax(loB, hiB, mm + 16);
        __syncthreads();
        const float mnA = ord2f(mm[2 * w]), mxA = ord2f(mm[2 * w + 1]), mnB = ord2f(mm[16 + 2 * w]), mxB = ord2f(mm[16 + 2 * w + 1]);
        select_token(sc + w * IDX_ROWW, hist, cand, tA + w + 1, mnA, mxA, IDX + (tokb + tA + w) * 256, lane);
        select_token(sc + w * IDX_ROWW + offB, hist, cand, tB + w + 1, mnB, mxB, IDX + (tokb + tB + w) * 256, lane);
        __syncthreads();
        if (c.tid < 32) mm[c.tid] = (c.tid & 1) ? (int)0x80000001 : 0x7fffffff;
        __syncthreads();
    }
}

__device__ __forceinline__ void sparse_attn_phase(const Ctx& c0, unsigned char* ws) {
    const Ctx c = launder(c0);
    constexpr int RP = 592;
    bf16_t* OA = (bf16_t*)(ws + WS_OA); const bf16_t* QR = (const bf16_t*)(ws + WS_QR); const bf16_t* CKV = (const bf16_t*)(ws + WS_CKV);
    const unsigned short* IDX = (const unsigned short*)(ws + WS_IDX);
    LAS unsigned char* buf = c.lds + c.wave * (32 * RP);
    const int lane = c.lane, hd = lane & 15, g = lane >> 4, hi = lane >> 5;
    const float sc = 0.08838834764831845f * LOG2E;
    int id0n = (c.gw < MTOK) ? (int)((const GAS unsigned short*)IDX)[(size_t)c.gw * 256 + (lane & 31)] : 0;
    for (int tok = c.gw; tok < MTOK; tok += c.NGW) {
        const int b = tok >> 12, t = tok & 4095, nsel = t + 1 < 256 ? t + 1 : 256, nch = (nsel + 31) >> 5;
        bf16x8 qf[9];
        { int ln = lane_id(); asm volatile("" : "+v"(ln)); const int hq = ln & 15, gq = ln >> 4;
#pragma unroll
          for (int s = 0; s < 8; ++s) qf[s] = (hq < 8) ? *(const GAS bf16x8*)(OA + (size_t)tok * LDOA + hq * 256 + 32 * s + 8 * gq) : (bf16x8){0, 0, 0, 0, 0, 0, 0, 0};
          qf[8] = (hq < 8) ? *(const GAS bf16x8*)(QR + (size_t)tok * 256 + hq * 32 + 8 * gq) : (bf16x8){0, 0, 0, 0, 0, 0, 0, 0}; }
        float m = NEGBIG, l = 0.f; f32x4 O[16];
#pragma unroll
        for (int d = 0; d < 16; ++d) O[d] = (f32x4){0.f, 0.f, 0.f, 0.f};
        const bf16_t* ckb = CKV + (size_t)b * SEQ * CKVP;
#define SA_GATHER(id_) do { const GAS unsigned char* cb_ = (const GAS unsigned char*)ckb;                  \
        _Pragma("unroll") for (int i = 0; i < 16; ++i) { const unsigned ra = (unsigned)__builtin_amdgcn_readlane((id_), 2 * i), rb = (unsigned)__builtin_amdgcn_readlane((id_), 2 * i + 1); const unsigned r = hi ? rb : ra; \
            unsigned of_ = __umul24(r, 576u) + lo16_; asm volatile("" : "+v"(of_)); tmp[i] = *(const GAS u32x4*)(cb_ + of_); } \
        _Pragma("unroll") for (int i = 0; i < 2; ++i) { const unsigned r = (unsigned)__shfl((id_), 16 * i + (lane >> 2)); unsigned of_ = __umul24(r, 576u) + 512u + t16_; asm volatile("" : "+v"(of_)); tmp[16 + i] = *(const GAS u32x4*)(cb_ + of_); } } while (0)
        const unsigned lo16_ = (unsigned)(lane & 31) * 16u, t16_ = (unsigned)(lane & 3) * 16u;
        u32x4 tmp[18];
        const GAS unsigned short* idp = (const GAS unsigned short*)(IDX + (size_t)tok * 256 + (lane & 31));
        { const int id0 = id0n; SA_GATHER(id0); }
        { const int tn = tok + c.NGW < MTOK ? tok + c.NGW : tok; id0n = (int)((const GAS unsigned short*)IDX)[(size_t)tn * 256 + (lane & 31)]; }
        int nid = (int)idp[nch > 1 ? 32 : 0];
        for (int ch = 0; ch < nch; ++ch) {
            asm volatile("" ::: "memory");
#pragma unroll
            for (int i = 0; i < 16; ++i) *(LAS u32x4*)(buf + (2 * i + hi) * RP + (lane & 31) * 16) = tmp[i];
#pragma unroll
            for (int i = 0; i < 2; ++i) *(LAS u32x4*)(buf + (16 * i + (lane >> 2)) * RP + 512 + (lane & 3) * 16) = tmp[16 + i];
            asm volatile("" ::: "memory");
            { const int nid2 = (int)idp[32 * ((ch + 2 < nch) ? ch + 2 : nch - 1)]; if (ch + 1 < nch) { SA_GATHER(nid); } nid = nid2; }
            __builtin_amdgcn_s_setprio(1);
            f32x4 S0 = {0.f, 0.f, 0.f, 0.f}, S1 = {0.f, 0.f, 0.f, 0.f};
#pragma unroll
            for (int s = 0; s < 9; ++s) {
                const bf16x8 a0 = *(const LAS bf16x8*)(buf + hd * RP + (32 * s + 8 * g) * 2);
                const bf16x8 a1 = *(const LAS bf16x8*)(buf + (16 + hd) * RP + (32 * s + 8 * g) * 2);
                S0 = __builtin_amdgcn_mfma_f32_16x16x32_bf16(a0, qf[s], S0, 0, 0, 0);
                S1 = __builtin_amdgcn_mfma_f32_16x16x32_bf16(a1, qf[s], S1, 0, 0, 0);
            }
            __builtin_amdgcn_sched_group_barrier(0x100, 4, 0);
#pragma unroll
            for (int i = 0; i < 7; ++i) { __builtin_amdgcn_sched_group_barrier(0x008, 2, 0); __builtin_amdgcn_sched_group_barrier(0x100, 2, 0); }
            __builtin_amdgcn_sched_group_barrier(0x008, 4, 0);
            __builtin_amdgcn_s_setprio(0);
            float mt = NEGBIG;
            const int kb = 32 * ch + 4 * g;
#pragma unroll
            for (int r = 0; r < 4; ++r) { S0[r] = (kb + r < nsel) ? S0[r] : NEGBIG; S1[r] = (kb + 16 + r < nsel) ? S1[r] : NEGBIG; mt = fmaxf(mt, fmaxf(S0[r], S1[r])); }
            mt = xmax32(xmax16(mt)) * sc;
            const float mn = fmaxf(m, mt);
            if (__any(mn > m + 8.0f)) { const float al = fexp2(m - mn); l *= al;
#pragma unroll
                for (int d = 0; d < 16; ++d) O[d] *= al;
                m = mn; }
            float ps = 0.f;
#pragma unroll
            for (int r = 0; r < 4; ++r) { S0[r] = fexp2(__builtin_fmaf(S0[r], sc, -m)); S1[r] = fexp2(__builtin_fmaf(S1[r], sc, -m)); ps += S0[r] + S1[r]; }
            l += ps;
            u32x4 pw; pw.x = cvt_pk_bf16(S0[0], S0[1]); pw.y = cvt_pk_bf16(S0[2], S0[3]); pw.z = cvt_pk_bf16(S1[0], S1[1]); pw.w = cvt_pk_bf16(S1[2], S1[3]);
            const bf16x8 pf = __builtin_bit_cast(bf16x8, pw);
            {
                const int qq = (lane & 15) >> 2, pp = lane & 3;
                const LAS unsigned char* vb = buf + (4 * g + qq) * RP + (4 * pp) * 2;
                __builtin_amdgcn_s_setprio(1);
#pragma unroll
                for (int d = 0; d < 16; ++d) {
                    const s16x4 lo = __builtin_amdgcn_ds_read_tr16_b64_v4i16((LAS s16x4*)(vb + d * 32));
                    const s16x4 h4 = __builtin_amdgcn_ds_read_tr16_b64_v4i16((LAS s16x4*)(vb + 16 * RP + d * 32));
                    const bf16x8 vf = (bf16x8){lo[0], lo[1], lo[2], lo[3], h4[0], h4[1], h4[2], h4[3]};
                    O[d] = __builtin_amdgcn_mfma_f32_16x16x32_bf16(vf, pf, O[d], 0, 0, 0);
                }
                __builtin_amdgcn_sched_group_barrier(0x100, 4, 0);
#pragma unroll
                for (int i = 0; i < 14; ++i) { __builtin_amdgcn_sched_group_barrier(0x008, 1, 0); __builtin_amdgcn_sched_group_barrier(0x100, 2, 0); }
                __builtin_amdgcn_sched_group_barrier(0x008, 2, 0);
                __builtin_amdgcn_s_setprio(0);
            }
        }
        l = xsum32(xsum16(l));
        const float il = 1.0f / l;
        { int lo_ = lane_id(); asm volatile("" : "+v"(lo_));
          asm volatile("" ::: "memory");
          if ((lo_ & 15) < 8) {
              LAS unsigned char* sp = buf + (lo_ & 15) * 528 + 8 * (lo_ >> 4);
#pragma unroll
              for (int d = 0; d < 16; ++d) { u32x2 w; w.x = cvt_pk_bf16(O[d][0] * il, O[d][1] * il); w.y = cvt_pk_bf16(O[d][2] * il, O[d][3] * il); *(LAS u32x2*)(sp + 32 * d) = w; }
          }
          asm volatile("" ::: "memory");
          bf16_t* o = OA + (size_t)tok * LDOA + (lo_ >> 5) * 256 + (lo_ & 31) * 8;
#pragma unroll
          for (int i = 0; i < 4; ++i) { const u32x4 v = *(const LAS u32x4*)(buf + (2 * i + (lo_ >> 5)) * 528 + (lo_ & 31) * 16); *(GAS u32x4*)(o + i * 512) = v; }
          asm volatile("" ::: "memory"); }
    }
}

#undef SA_GATHER
__device__ __forceinline__ void glu_phase(const Ctx& c0, unsigned char* ws, const float* cw, const float* cb) {
    const Ctx c = launder(c0);
    const bf16_t* AH = (const bf16_t*)(ws + WS_AH); bf16_t* BH = (bf16_t*)(ws + WS_BH);
    const int gt = c.gw * 64 + c.lane, NGT = c.NGW * 64;
    constexpr int CV = FF / 8;
    for (int i = gt; i < 16384 * CV; i += NGT) {
        const int r = i / CV, cv = i % CV, col = cv * 8, t = r & 4095;
        const u32x4 a0 = *(const GAS u32x4*)(AH + (size_t)r * FF + col);
        const u32x4 a1 = (t >= 1) ? *(const GAS u32x4*)(AH + (size_t)(r - 1) * FF + col) : (u32x4){0u, 0u, 0u, 0u};
        const u32x4 a2 = (t >= 2) ? *(const GAS u32x4*)(AH + (size_t)(r - 2) * FF + col) : (u32x4){0u, 0u, 0u, 0u};
        const u32x4 bb = *(const GAS u32x4*)(BH + (size_t)r * FF + col);
        float w0[8], w1[8], w2[8], bi[8];
#pragma unroll
        for (int e = 0; e < 2; ++e) { const f32x4 x0 = *(const GAS f32x4*)(cw + col + 4 * e), x1 = *(const GAS f32x4*)(cw + FF + col + 4 * e), x2 = *(const GAS f32x4*)(cw + 2 * FF + col + 4 * e), x3 = *(const GAS f32x4*)(cb + col + 4 * e);
#pragma unroll
            for (int q = 0; q < 4; ++q) { w0[4 * e + q] = x0[q]; w1[4 * e + q] = x1[q]; w2[4 * e + q] = x2[q]; bi[4 * e + q] = x3[q]; } }
        u32x4 o;
#pragma unroll
        for (int e = 0; e < 4; ++e) {
            const float c0 = w0[2 * e] * bflo(a2[e]) + w1[2 * e] * bflo(a1[e]) + w2[2 * e] * bflo(a0[e]) + bi[2 * e];
            const float c1 = w0[2 * e + 1] * bfhi(a2[e]) + w1[2 * e + 1] * bfhi(a1[e]) + w2[2 * e + 1] * bfhi(a0[e]) + bi[2 * e + 1];
            const float g0 = c0 * __builtin_amdgcn_rcpf(1.0f + fexp2(-c0 * LOG2E)) * bflo(bb[e]);
            const float g1 = c1 * __builtin_amdgcn_rcpf(1.0f + fexp2(-c1 * LOG2E)) * bfhi(bb[e]);
            o[e] = cvt_pk_bf16(g0, g1);
        }
        *(GAS u32x4*)(BH + (size_t)r * FF + col) = o;
    }
}

__global__ void __launch_bounds__(NTHR, 2) fwd_kernel(Args a_unused) {
    extern __shared__ __attribute__((aligned(16))) unsigned char lds_raw[];
    Ctx c;
    c.lds = (LAS unsigned char*)lds_raw;
    c.tid = threadIdx.x; c.lane = c.tid & 63; c.wave = __builtin_amdgcn_readfirstlane(c.tid >> 6);
    c.G = gridDim.x; { const int bx = blockIdx.x; c.vcu = (c.G % 8 == 0) ? (bx % 8) * (c.G / 8) + bx / 8 : bx; }
    c.gw = c.vcu * NWAVES + c.wave; c.NGW = c.G * NWAVES;
    volatile LAS unsigned* MISC = (volatile LAS unsigned*)(c.lds + MISC_OFF);
    if (c.tid < 32) MISC[c.tid] = 0u;
    __syncthreads();
    unsigned char* ws = gptr(argp()->ws);
    XcdBarrier bar = xcd_barrier_post((unsigned*)(ws + WS_CTL) + CW_BAR, MISC + 8); bar.wave = c.wave;
    int ph = 0;
    const int lo = argp()->ph_lo, hi = argp()->ph_hi;
#define PHASE_BEGIN if (ph >= lo && ph < hi) {
#define PHASE_END   if (ph + 1 < hi) xcd_barrier(bar); } ++ph;

    PHASE_BEGIN prologue1(c); PHASE_END
    PHASE_BEGIN prologue2(c, ws); PHASE_END

#pragma nounroll
    for (int l = 0; l < DEPTH; ++l) {
        asm volatile("" : "+s"(ws)); ws = gptr(ws);
        const int kind = l % 3, j = l / 3;
        unsigned char* wl = ws + WS_WT + (size_t)l * WT_LAYER;
        const bf16_t* kvm = (const bf16_t*)(ws + WS_KVM + (size_t)l * 2 * MiB);
        PHASE_BEGIN
        { const int N = kind == 0 ? NA_IN : kind == 1 ? NB_IN : NC_IN;
          pg8::Gemm g{(const bf16_t*)(ws + WS_XN), (const bf16_t*)(wl + WT_IN), DM, DM, DM}; pg8::StaticOrder S; S.init(MTOK, N, c.G, (int)blockIdx.x);
          EpiIn E{kind, ws, c.lds + 8 * pg8::HTB, (const float*)(ws + WS_SSP)}; pg8::gemm_phase<EpiIn, pg8::StaticOrder>(c.lds, g, S, E, c.wave); }
        PHASE_END
        if (kind == 0) {
            PHASE_BEGIN
            ckv_norm_rows(c, ws, gptr(argp()->a_kv_norm) + (size_t)j * 256);
            mem_attn_lds(c, (bf16_t*)(ws + WS_OA), LDOA, 2048, kvm);
            __syncthreads();
            indexer_phase(c, ws);
            PHASE_END
            PHASE_BEGIN sparse_attn_phase(c, ws); PHASE_END
        } else if (kind == 1) {
            PHASE_BEGIN
            mem_attn_lds(c, (bf16_t*)(ws + WS_OB), LDOB, 1024, kvm);
            swa_units(c, ws, gptr(argp()->b_sinks) + (size_t)j * 16);
            PHASE_END
        } else {
            PHASE_BEGIN
            mem_attn_lds(c, (bf16_t*)(ws + WS_OC), LDOB, 1024, kvm);
            dil_units(c, ws, (bf16_t*)gptr(argp()->out), 0, 2);
            PHASE_END
            PHASE_BEGIN dil_units(c, ws, (bf16_t*)gptr(argp()->out), 2, 3); PHASE_END
        }
        PHASE_BEGIN
        { const int K = kind == 0 ? LDOA : LDOB;
          pg8::Gemm g{(const bf16_t*)(ws + WS_ACT), (const bf16_t*)(wl + WT_OUT), K, K, K}; pg8::StaticOrder S; S.init(MTOK, DM, c.G, (int)blockIdx.x);
          EpiRes E{(bf16_t*)(ws + WS_XN), (float*)(ws + WS_SSP)}; pg8::gemm_phase<EpiRes, pg8::StaticOrder>(c.lds, g, S, E, c.wave); }
        PHASE_END
        PHASE_BEGIN
        { pg8::Gemm g{(const bf16_t*)(ws + WS_XN), (const bf16_t*)(wl + WT_UP), DM, DM, DM}; pg8::OvlOrder S; S.init(BATCH * 17, 22, c.G, (int)blockIdx.x);
          EpiGlu E{(bf16_t*)(ws + WS_G), (const float*)(ws + WS_SSP), gptr(argp()->f_conv_w) + (size_t)l * 3 * FF, gptr(argp()->f_conv_b) + (size_t)l * FF, c.lds + 8 * pg8::HTB};
          pg8::gemm_phase<EpiGlu, pg8::OvlOrder>(c.lds, g, S, E, c.wave); }
        PHASE_END
        PHASE_BEGIN
        { pg8::Gemm g{(const bf16_t*)(ws + WS_G), (const bf16_t*)(wl + WT_DOWN), FF, FF, FF}; pg8::StaticOrder S; S.init(MTOK, DM, c.G, (int)blockIdx.x);
          EpiRes E{(bf16_t*)(ws + WS_XN), (float*)(ws + WS_SSP)}; pg8::gemm_phase<EpiRes, pg8::StaticOrder>(c.lds, g, S, E, c.wave); }
        PHASE_END
    }
    if (ph >= lo && ph < hi) final_norm_phase(c, (const bf16_t*)(ws + WS_XN), (const float*)(ws + WS_SSP), gptr(argp()->g_final), gptr(argp()->out));
#undef PHASE_BEGIN
#undef PHASE_END
}

extern "C" void kernel_launch(void* const* d_in, const int* in_sizes, int n_in, void* d_out, int out_size, void* d_ws, size_t ws_size, hipStream_t stream) {
    static int grid = 0;
    if (grid == 0) {
        if (n_in != 22 || ws_size < WS_END) { fprintf(stderr, "kernel_launch: unexpected n_in %d or ws_size %zu\n", n_in, ws_size); grid = -1; return; }
        int dev = 0, cus = 0, per_cu = 0;
        if (hipGetDevice(&dev) != hipSuccess || hipDeviceGetAttribute(&cus, hipDeviceAttributeMultiprocessorCount, dev) != hipSuccess) { grid = -1; return; }
        if (hipFuncSetAttribute((const void*)fwd_kernel, hipFuncAttributeMaxDynamicSharedMemorySize, LDS_BYTES) != hipSuccess) { fprintf(stderr, "kernel_launch: hipFuncSetAttribute failed\n"); grid = -1; return; }
        if (hipOccupancyMaxActiveBlocksPerMultiprocessor(&per_cu, (const void*)fwd_kernel, NTHR, LDS_BYTES) != hipSuccess || per_cu < 1)
            fprintf(stderr, "kernel_launch: occupancy query reports %d\n", per_cu);
        (void)hipGetLastError();
        grid = cus;
    }
    if (grid < 0) return;
    (void)hipMemsetAsync((char*)d_ws + WS_CTL, 0, CTL_ZERO_BYTES, stream);
    Args a{};
    a.x = (const float*)d_in[0]; a.mem = (const float*)d_in[1]; a.positions = (const int*)d_in[2];
    a.g_mix = (const float*)d_in[3]; a.g_ffn = (const float*)d_in[4]; a.g_mem = (const float*)d_in[5]; a.g_final = (const float*)d_in[6]; a.w_mem_kv = (const float*)d_in[7];
    a.a_w_in = (const float*)d_in[8]; a.a_kv_norm = (const float*)d_in[9]; a.a_w_uk = (const float*)d_in[10]; a.a_w_uv = (const float*)d_in[11]; a.a_w_out = (const float*)d_in[12];
    a.b_w_in = (const float*)d_in[13]; a.b_sinks = (const float*)d_in[14]; a.b_w_out = (const float*)d_in[15]; a.c_w_in = (const float*)d_in[16]; a.c_w_out = (const float*)d_in[17];
    a.f_w_up = (const float*)d_in[18]; a.f_conv_w = (const float*)d_in[19]; a.f_conv_b = (const float*)d_in[20]; a.f_w_down = (const float*)d_in[21];
    a.out = (float*)d_out; a.ws = (unsigned char*)d_ws;
    a.ph_lo = 0; a.ph_hi = 1000;
    hipLaunchKernelGGL(fwd_kernel, dim3(grid), dim3(NTHR), LDS_BYTES, stream, a);
}
```
